# Optimizing an MI355X kernel written in HIP

```python
import math
import jax, jax.numpy as jnp
from jax import lax
import numpy as np

D_MODEL = 1024
BATCH = 8
SEQ = 8192
DEPTH = 2

CHUNK = 64
MEM_LEN = 256
Q_BLOCK = 128
N_BRANCH = 4
BRANCH_W = D_MODEL // 2
N_IN_PIECES = 12
IN_COLS = N_IN_PIECES * BRANCH_W + N_BRANCH * D_MODEL
SSM_GROUP = 16
SSM_GROUPS = BRANCH_W // SSM_GROUP
SSM_STATE = 64
DT_MIN = 1e-3
DT_MAX = 1e-1
RET_HEADS = 4
RET_DK = BRANCH_W // RET_HEADS
RET_DV = BRANCH_W // RET_HEADS
DIFF_HEADS = 4
DIFF_DH = BRANCH_W // (2 * DIFF_HEADS)
DIFF_DV = 2 * DIFF_DH
MEM_HEADS = 4
MEM_DH = BRANCH_W // MEM_HEADS
ROPE_THETA = 10000.0
EPS = 1e-6
NEG_INF = -1e30

kernel_name = "hybrid_s5_retention_diffattn_memory_trunk"


def rms_norm(x, g=None):
    x32 = x.astype(jnp.float32)
    y = x32 * lax.rsqrt(jnp.mean(x32 * x32, axis=-1, keepdims=True) + EPS)
    if g is not None:
        y = y * g.astype(jnp.float32)
    return y.astype(x.dtype)


def rope_tables(seq, inv_freq):
    pos = jnp.arange(seq, dtype=jnp.float32)
    ang = pos[:, None] * inv_freq[None, :]
    return jnp.cos(ang), jnp.sin(ang)


def rope(x, cos, sin):
    shape = (x.shape[1],) + (1,) * (x.ndim - 3) + (cos.shape[-1],)
    c = cos.reshape(shape)
    s = sin.reshape(shape)
    x1, x2 = jnp.split(x, 2, axis=-1)
    return jnp.concatenate([x1 * c - x2 * s, x2 * c + x1 * s], axis=-1).astype(x.dtype)


def _ssm_combine(left, right):
    ar_l, ai_l, br_l, bi_l = left
    ar_r, ai_r, br_r, bi_r = right
    ar = ar_r * ar_l - ai_r * ai_l
    ai = ar_r * ai_l + ai_r * ar_l
    br = ar_r * br_l - ai_r * bi_l + br_r
    bi = ar_r * bi_l + ai_r * br_l + bi_r
    return (ar, ai, br, bi)


def s5_branch(u, lam_re, lam_im, log_dt, b_re, b_im, c_re, c_im, d_skip, w_glu, b_glu):
    f32 = jnp.float32
    bsz, seq, _ = u.shape
    u32 = u.astype(f32)
    ug = u32.reshape(bsz, seq, SSM_GROUPS, SSM_GROUP)
    lr = jnp.minimum(lam_re.astype(f32), -1e-4)
    li = lam_im.astype(f32)
    dt = jnp.exp(log_dt.astype(f32))[:, None]
    mag = jnp.exp(lr * dt)
    ab_re = mag * jnp.cos(li * dt)
    ab_im = mag * jnp.sin(li * dt)
    nr = ab_re - 1.0
    ni = ab_im
    den = lr * lr + li * li
    f_re = (nr * lr + ni * li) / den
    f_im = (ni * lr - nr * li) / den
    br_ = b_re.astype(f32)
    bi_ = b_im.astype(f32)
    bb_re = f_re[:, :, None] * br_ - f_im[:, :, None] * bi_
    bb_im = f_re[:, :, None] * bi_ + f_im[:, :, None] * br_
    bu_re = jnp.einsum('bsgh,gph->bsgp', ug, bb_re)
    bu_im = jnp.einsum('bsgh,gph->bsgp', ug, bb_im)
    a_re = jnp.broadcast_to(ab_re, bu_re.shape)
    a_im = jnp.broadcast_to(ab_im, bu_im.shape)
    _, _, xr, xi = lax.associative_scan(_ssm_combine, (a_re, a_im, bu_re, bu_im), axis=1)
    y = (jnp.einsum('bsgp,ghp->bsgh', xr, c_re.astype(f32))
         - jnp.einsum('bsgp,ghp->bsgh', xi, c_im.astype(f32)))
    y = y.reshape(bsz, seq, BRANCH_W) + d_skip.astype(f32) * u32
    z = jax.nn.gelu(y)
    out = z * jax.nn.sigmoid(jnp.einsum('bsc,ce->bse', z, w_glu.astype(f32)) + b_glu.astype(f32))
    return out.astype(u.dtype)


def retention_branch(q, k, v, cos, sin):
    f32 = jnp.float32
    bsz, seq = q.shape[0], q.shape[1]
    n_chunks = seq // CHUNK
    qr = rope(q.astype(f32), cos, sin)
    kr = rope(k.astype(f32), cos, sin) * (RET_DK ** -0.5)
    v32 = v.astype(f32)
    log_gamma = jnp.log1p(-(2.0 ** (-5.0 - jnp.arange(RET_HEADS, dtype=f32))))
    idx = jnp.arange(CHUNK, dtype=f32)
    intra = jnp.exp(jnp.abs(idx[:, None] - idx[None, :])[None] * log_gamma[:, None, None])
    q_dec = jnp.exp((idx + 1.0)[None, :] * log_gamma[:, None])
    k_dec = jnp.exp((CHUNK - 1.0 - idx)[None, :] * log_gamma[:, None])
    chunk_dec = jnp.exp(CHUNK * log_gamma)

    def to_chunks(t):
        return t.reshape(bsz, n_chunks, CHUNK, RET_HEADS, t.shape[-1]).transpose(1, 0, 3, 2, 4)

    def step(state, xs):
        qc, kc, vc = xs
        scores = jnp.einsum('bhid,bhjd->bhij', qc, kc) * intra[None]
        o = (jnp.einsum('bhij,bhjv->bhiv', scores, vc)
             + jnp.einsum('bhid,bhdv->bhiv', qc, state) * q_dec[None, :, :, None])
        state = (state * chunk_dec[None, :, None, None]
                 + jnp.einsum('bhjd,bhjv->bhdv', kc * k_dec[None, :, :, None], vc))
        return state, o

    state0 = jnp.zeros((bsz, RET_HEADS, RET_DK, RET_DV), f32)
    _, o = lax.scan(step, state0, (to_chunks(qr), to_chunks(kr), to_chunks(v32)))
    o = o.transpose(1, 0, 3, 2, 4).reshape(bsz, seq, RET_HEADS, RET_DV)
    o = rms_norm(o)
    return o.reshape(bsz, seq, RET_HEADS * RET_DV).astype(q.dtype)


def diff_attn_branch(q, k, v, cos, sin, qn_g, kn_g, lq1, lk1, lq2, lk2, hn_g, lambda_init):
    f32 = jnp.float32
    bsz, seq = q.shape[0], q.shape[1]
    n_blocks = seq // Q_BLOCK
    qr = rope(rms_norm(q, qn_g), cos, sin) * (DIFF_DH ** -0.5)
    kr = rope(rms_norm(k, kn_g), cos, sin)
    lam = (jnp.exp(jnp.sum(lq1.astype(f32) * lk1.astype(f32)))
           - jnp.exp(jnp.sum(lq2.astype(f32) * lk2.astype(f32))) + lambda_init)
    key_chunk = jnp.arange(seq) // CHUNK
    qb = qr.reshape(bsz, n_blocks, Q_BLOCK, DIFF_HEADS, 2, DIFF_DH).transpose(1, 0, 2, 3, 4, 5)

    def attend(args):
        q_blk, blk = args
        q_chunk = (blk * Q_BLOCK + jnp.arange(Q_BLOCK)) // CHUNK
        mask = key_chunk[None, :] <= q_chunk[:, None]
        s = jnp.einsum('bqhmd,bkhmd->bhmqk', q_blk, kr).astype(f32)
        s = jnp.where(mask, s, NEG_INF)
        p = jax.nn.softmax(s, axis=-1)
        a = p[:, :, 0] - lam * p[:, :, 1]
        return jnp.einsum('bhqk,bkhv->bqhv', a.astype(v.dtype), v)

    o = lax.map(attend, (qb, jnp.arange(n_blocks)))
    o = o.transpose(1, 0, 2, 3, 4).reshape(bsz, seq, DIFF_HEADS, DIFF_DV)
    o = rms_norm(o, hn_g) * (1.0 - lambda_init)
    return o.reshape(bsz, seq, DIFF_HEADS * DIFF_DV).astype(q.dtype)


def memory_branch(q, mem_n, w_mem_kv, qn_g, kn_g):
    bsz, seq = q.shape[0], q.shape[1]
    m = mem_n.shape[1]
    kv = jnp.einsum('bmd,dc->bmc', mem_n, w_mem_kv)
    mk, mv = jnp.split(kv, 2, axis=-1)
    mk = rms_norm(mk.reshape(bsz, m, MEM_HEADS, MEM_DH), kn_g)
    mv = mv.reshape(bsz, m, MEM_HEADS, MEM_DH)
    qh = rms_norm(q.reshape(bsz, seq, MEM_HEADS, MEM_DH), qn_g) * (MEM_DH ** -0.5)
    s = jnp.einsum('bshd,bmhd->bhsm', qh, mk).astype(jnp.float32)
    p = jax.nn.softmax(s, axis=-1)
    o = jnp.einsum('bhsm,bmhd->bshd', p.astype(mv.dtype), mv)
    return o.reshape(bsz, seq, BRANCH_W).astype(q.dtype)


def setup_inputs(seed: int = 0) -> dict:
    key = jax.random.key(seed)
    ks = jax.random.split(key, 32)
    f32 = jnp.float32
    nrm = lambda k, shape, scale: jax.random.normal(k, shape, f32) * scale
    gain = lambda k, shape: 1.0 + 0.02 * jax.random.normal(k, shape, f32)
    lam_im_base = math.pi * jnp.arange(SSM_STATE, dtype=f32)
    return {
        "x": nrm(ks[0], (BATCH, SEQ, D_MODEL), 1.0),
        "mem": nrm(ks[1], (BATCH, MEM_LEN, D_MODEL), 1.0),
        "norm_g": gain(ks[2], (DEPTH, D_MODEL)),
        "w_in": nrm(ks[3], (DEPTH, D_MODEL, IN_COLS), D_MODEL ** -0.5),
        "ssm_lambda_re": -0.5 + 0.01 * jax.random.normal(ks[4], (DEPTH, SSM_GROUPS, SSM_STATE), f32),
        "ssm_lambda_im": lam_im_base[None, None, :] + 0.01 * jax.random.normal(ks[5], (DEPTH, SSM_GROUPS, SSM_STATE), f32),
        "ssm_log_dt": jax.random.uniform(ks[6], (DEPTH, SSM_GROUPS), f32, minval=math.log(DT_MIN), maxval=math.log(DT_MAX)),
        "ssm_b_re": nrm(ks[7], (DEPTH, SSM_GROUPS, SSM_STATE, SSM_GROUP), (2 * SSM_GROUP) ** -0.5),
        "ssm_b_im": nrm(ks[8], (DEPTH, SSM_GROUPS, SSM_STATE, SSM_GROUP), (2 * SSM_GROUP) ** -0.5),
        "ssm_c_re": nrm(ks[9], (DEPTH, SSM_GROUPS, SSM_GROUP, SSM_STATE), SSM_STATE ** -0.5),
        "ssm_c_im": nrm(ks[10], (DEPTH, SSM_GROUPS, SSM_GROUP, SSM_STATE), SSM_STATE ** -0.5),
        "ssm_d": nrm(ks[11], (DEPTH, BRANCH_W), 1.0),
        "ssm_w_glu": nrm(ks[12], (DEPTH, BRANCH_W, BRANCH_W), BRANCH_W ** -0.5),
        "ssm_b_glu": nrm(ks[13], (DEPTH, BRANCH_W), 0.01),
        "diff_q_norm_g": gain(ks[14], (DEPTH, DIFF_DH)),
        "diff_k_norm_g": gain(ks[15], (DEPTH, DIFF_DH)),
        "diff_lambda_q1": nrm(ks[16], (DEPTH, DIFF_DH), 0.1),
        "diff_lambda_k1": nrm(ks[17], (DEPTH, DIFF_DH), 0.1),
        "diff_lambda_q2": nrm(ks[18], (DEPTH, DIFF_DH), 0.1),
        "diff_lambda_k2": nrm(ks[19], (DEPTH, DIFF_DH), 0.1),
        "diff_head_norm_g": gain(ks[20], (DEPTH, DIFF_DV)),
        "mem_norm_g": gain(ks[21], (DEPTH, D_MODEL)),
        "w_mem_kv": nrm(ks[22], (DEPTH, D_MODEL, 2 * BRANCH_W), D_MODEL ** -0.5),
        "mem_q_norm_g": gain(ks[23], (DEPTH, MEM_DH)),
        "mem_k_norm_g": gain(ks[24], (DEPTH, MEM_DH)),
        "w_branch": nrm(ks[25], (DEPTH, N_BRANCH, BRANCH_W, D_MODEL), BRANCH_W ** -0.5),
        "b_merge": nrm(ks[26], (DEPTH, N_BRANCH, D_MODEL), 0.01),
        "w_out": nrm(ks[27], (DEPTH, D_MODEL, D_MODEL), D_MODEL ** -0.5),
    }


def reference(x, mem, norm_g, w_in, ssm_lambda_re, ssm_lambda_im, ssm_log_dt, ssm_b_re, ssm_b_im,
              ssm_c_re, ssm_c_im, ssm_d, ssm_w_glu, ssm_b_glu, diff_q_norm_g, diff_k_norm_g,
              diff_lambda_q1, diff_lambda_k1, diff_lambda_q2, diff_lambda_k2, diff_head_norm_g,
              mem_norm_g, w_mem_kv, mem_q_norm_g, mem_k_norm_g, w_branch, b_merge, w_out):
    f32 = jnp.float32
    bsz, seq, _ = x.shape
    diff_inv = ROPE_THETA ** (-jnp.arange(0, DIFF_DH, 2, dtype=f32) / DIFF_DH)
    d_cos, d_sin = rope_tables(seq, diff_inv)
    ret_inv = 1.0 / (ROPE_THETA ** jnp.linspace(0.0, 1.0, RET_DK // 2, dtype=f32))
    r_cos, r_sin = rope_tables(seq, ret_inv)
    split_at = [BRANCH_W * i for i in range(1, N_IN_PIECES + 1)]

    for l in range(DEPTH):
        lambda_init = 0.8 - 0.6 * math.exp(-0.3 * l)
        h = rms_norm(x, norm_g[l])
        proj = jnp.einsum('bsd,dc->bsc', h, w_in[l])
        (ssm_u, ssm_gate, ret_q, ret_k, ret_v, ret_gate, diff_q, diff_k, diff_v, diff_gate,
         mem_q, mem_gate, merge) = jnp.split(proj, split_at, axis=-1)

        a_out = s5_branch(ssm_u, ssm_lambda_re[l], ssm_lambda_im[l], ssm_log_dt[l], ssm_b_re[l],
                          ssm_b_im[l], ssm_c_re[l], ssm_c_im[l], ssm_d[l], ssm_w_glu[l], ssm_b_glu[l])
        a_out = a_out * jax.nn.silu(ssm_gate)

        b_out = retention_branch(ret_q.reshape(bsz, seq, RET_HEADS, RET_DK),
                                 ret_k.reshape(bsz, seq, RET_HEADS, RET_DK),
                                 ret_v.reshape(bsz, seq, RET_HEADS, RET_DV), r_cos, r_sin)
        b_out = b_out * jax.nn.silu(ret_gate)

        c_out = diff_attn_branch(diff_q.reshape(bsz, seq, DIFF_HEADS, 2, DIFF_DH),
                                 diff_k.reshape(bsz, seq, DIFF_HEADS, 2, DIFF_DH),
                                 diff_v.reshape(bsz, seq, DIFF_HEADS, DIFF_DV), d_cos, d_sin,
                                 diff_q_norm_g[l], diff_k_norm_g[l], diff_lambda_q1[l], diff_lambda_k1[l],
                                 diff_lambda_q2[l], diff_lambda_k2[l], diff_head_norm_g[l], lambda_init)
        c_out = c_out * jax.nn.silu(diff_gate)

        mem_n = rms_norm(mem, mem_norm_g[l])
        m_out = memory_branch(mem_q, mem_n, w_mem_kv[l], mem_q_norm_g[l], mem_k_norm_g[l])
        m_out = m_out * jax.nn.silu(mem_gate)

        branches = jnp.stack([a_out, b_out, c_out, m_out], axis=2)
        br = jnp.einsum('bsnc,ncd->bsnd', branches, w_branch[l])
        gates = jax.nn.sigmoid(merge.reshape(bsz, seq, N_BRANCH, D_MODEL) + b_merge[l])
        merged = jnp.sum(gates * br, axis=2)
        x = (x + jnp.einsum('bsd,de->bse', merged, w_out[l])).astype(x.dtype)
    return x
```

```cpp
#include <hip/hip_runtime.h>
#include <hip/hip_cooperative_groups.h>
#include <cstdio>
namespace cg = cooperative_groups;
#define LAS __attribute__((address_space(3)))
#define DI __device__ __forceinline__
typedef unsigned short bf16_t;
typedef short bf16x8 __attribute__((ext_vector_type(8)));
typedef short s16x4 __attribute__((ext_vector_type(4)));
typedef float f32x4 __attribute__((ext_vector_type(4)));
typedef float f32x16 __attribute__((ext_vector_type(16)));
typedef unsigned u32x4 __attribute__((ext_vector_type(4)));
typedef unsigned u32x2 __attribute__((ext_vector_type(2)));

constexpr int DM = 1024, NBATCH = 8, SEQ = 8192, DEPTH = 2, BW = 512, INC = 10240, MEML = 256;
constexpr int SLABB = 4, TS = SLABB * SEQ  , NSLAB = NBATCH / SLABB;
constexpr float EPSN = 1e-6f;

DI float bf2f(bf16_t b) { return __uint_as_float(((unsigned)b) << 16); }
DI bf16_t f2bf(float f) { unsigned u = __float_as_uint(f); u += 0x7FFFu + ((u >> 16) & 1u); return (bf16_t)(u >> 16); }
typedef __bf16 bf16n2 __attribute__((ext_vector_type(2)));
typedef float f32x2 __attribute__((ext_vector_type(2)));
DI unsigned pk2(float lo, float hi) { const f32x2 v = {lo, hi}; return __builtin_bit_cast(unsigned, __builtin_convertvector(v, bf16n2)); }
DI float lo2f(unsigned w) { return __uint_as_float(w << 16); }
DI float hi2f(unsigned w) { return __uint_as_float(w & 0xffff0000u); }
DI float sigmoidf_(float v) { return __builtin_amdgcn_rcpf(1.0f + __expf(-v)); }
DI float siluf_(float v) { return v * sigmoidf_(v); }
DI int opaque_tid() { int t = threadIdx.x; asm volatile("" : "+v"(t)); return t; }
DI float shx(float v, int m) { return __int_as_float(__builtin_amdgcn_ds_bpermute(((opaque_tid() & 63) ^ m) << 2, __float_as_int(v))); }
DI unsigned shl_u(unsigned v, int src) { return (unsigned)__builtin_amdgcn_ds_bpermute(src << 2, (int)v); }
DI float wave_sum(float v) { for (int o = 32; o > 0; o >>= 1) v += shx(v, o); return v; }
DI float wave_max(float v) { for (int o = 32; o > 0; o >>= 1) v = fmaxf(v, shx(v, o)); return v; }

namespace pg8 {
constexpr int BM = 256, BK = 64, HALF = 128, HTB = HALF * BK * 2, STAGE_BYTES = 8 * HTB, NXCD = 8, WGM = 8;
__host__ __device__ __forceinline__ int lds_byte(int r, int c) { const int st = (r >> 4) * 2 + (c >> 5), rr = r & 15, cc = c & 31, ob = rr * 64 + cc * 2; return st * 1024 + (ob ^ (((ob >> 9) & 1) << 5)); }
__host__ __device__ __forceinline__ void stage_rc(int b, int& R, int& C) { const int st = b / 1024, sb = b % 1024, swz = sb ^ (((sb >> 9) & 1) << 5); R = (st >> 1) * 16 + swz / 64; C = (st & 1) * 32 + (swz % 64) / 2; }
__host__ __device__ __forceinline__ int perm32(int rho) { const int n = rho >> 4, i = rho & 15; return 8 * (i >> 2) + 4 * n + (i & 3); }

struct Unit { const char* A; const char* B; int row0, col0, aux; };

DI void tile_of(int L, int nM, int nN, int& pm, int& pn) {
    const int nwg = nM * nN; int wgid = L; { const int q = nwg / NXCD, r = nwg % NXCD, xcd = wgid % NXCD, off = wgid / NXCD; wgid = (xcd < r ? xcd * (q + 1) : r * (q + 1) + (xcd - r) * q) + off; }
    const int nig = WGM * nN, gid = wgid / nig, fm = gid * WGM, gsz = (nM - fm) < WGM ? (nM - fm) : WGM;
    pm = fm + ((wgid % nig) % gsz); pn = (wgid % nig) / gsz;
}

template <class Epi, class Sched>
DI void gemm_phase(LAS unsigned char* lds, const int K, const Sched& S, const Epi& E) {
    const int tid = opaque_tid(), wid = __builtin_amdgcn_readfirstlane(tid >> 6), lane = tid & 63, wr = wid >> 2, wc = wid & 3, fr = lane & 15, fq = lane >> 4;
    const int nt = K / BK;
    unsigned voffA[2], voffB[2];
#pragma unroll
    for (int i = 0; i < 2; ++i) { int R, C; stage_rc(tid * 16 + i * 8192, R, C); const int Rb = Epi::PERM ? ((R & ~31) + perm32(R & 31)) : R;
        voffA[i] = (unsigned)(R * K + C) * 2u; voffB[i] = (unsigned)(Rb * K + C) * 2u; }
    const size_t kstep = (size_t)(BK * 2);
    const size_t hstep = (size_t)HALF * K * 2;
    const unsigned ldsw = (unsigned)wid * 1024u;
    const int aoff = lds_byte(wr * 64 + fr, fq * 8), boff = lds_byte(wc * 32 + fr, fq * 8);
#define PG8_SA(b, h) (((b) * 2 + (h)) * HTB)
#define PG8_SB(b, h) ((4 + (b) * 2 + (h)) * HTB)
#define PG8_STAGE(bufoff, gbase, voff) do { _Pragma("unroll") for (int _i = 0; _i < 2; ++_i) \
        __builtin_amdgcn_global_load_lds((const unsigned*)((const char*)(gbase) + (voff)[_i]), (LAS unsigned*)(lds + (bufoff) + ldsw + _i * 8192), 16, 0, 0); } while (0)
#define PG8_LDA(dst, b, h) do { _Pragma("unroll") for (int m = 0; m < 4; ++m) _Pragma("unroll") for (int k = 0; k < 2; ++k) dst[m][k] = *(const LAS bf16x8*)(lds + PG8_SA(b, h) + aoff + m * 2048 + k * 1024); } while (0)
#define PG8_LDB(dst, b, h) do { _Pragma("unroll") for (int n = 0; n < 2; ++n) _Pragma("unroll") for (int k = 0; k < 2; ++k) dst[n][k] = *(const LAS bf16x8*)(lds + PG8_SB(b, h) + boff + n * 2048 + k * 1024); } while (0)
#define PG8_MMA(ai, bj, At, Bt) do { __builtin_amdgcn_s_setprio(1); _Pragma("unroll") for (int m = 0; m < 4; ++m) _Pragma("unroll") for (int n = 0; n < 2; ++n) _Pragma("unroll") for (int k = 0; k < 2; ++k) \
        acc[ai][bj][m][n] = __builtin_amdgcn_mfma_f32_16x16x32_bf16(Bt[n][k], At[m][k], acc[ai][bj][m][n], 0, 0, 0); __builtin_amdgcn_s_setprio(0); } while (0)
#define PG8_WAIT_V(n) asm volatile("s_waitcnt vmcnt(" #n ")" ::: "memory")
#define PG8_WAIT_L(n) asm volatile("s_waitcnt lgkmcnt(" #n ")" ::: "memory")
#define PG8_BAR __builtin_amdgcn_s_barrier()
#define PG8_SCHED __builtin_amdgcn_sched_barrier(0)
    Unit cur, nxt; int ui = 0;
    if (!S.next(0, cur)) return;
    f32x4 acc[2][2][4][2];
#pragma unroll
    for (int a = 0; a < 2; ++a)
#pragma unroll
        for (int b = 0; b < 2; ++b)
#pragma unroll
            for (int m = 0; m < 4; ++m)
#pragma unroll
                for (int n = 0; n < 2; ++n) acc[a][b][m][n] = (f32x4){0.f, 0.f, 0.f, 0.f};
    bf16x8 At[4][2], B0[2][2], B1[2][2];
    const char* cA = cur.A; const char* cB = cur.B;
    PG8_STAGE(PG8_SB(0, 0), cB, voffB); PG8_STAGE(PG8_SA(0, 0), cA, voffA); PG8_STAGE(PG8_SB(0, 1), cB + hstep, voffB); PG8_STAGE(PG8_SA(0, 1), cA + hstep, voffA);
    if (wr == 1) PG8_BAR;
    PG8_WAIT_V(4); PG8_BAR;
    PG8_STAGE(PG8_SB(1, 0), cB + kstep, voffB); PG8_STAGE(PG8_SA(1, 0), cA + kstep, voffA); PG8_STAGE(PG8_SB(1, 1), cB + hstep + kstep, voffB);
    PG8_WAIT_V(6); PG8_BAR;
    for (;;) {
        const bool has_next = S.next(ui + 1, nxt);
        const char* nA = has_next ? nxt.A : cA; const char* nB = has_next ? nxt.B : cB;
        for (int t = 0; t < nt; t += 2) {
            const bool last = (t == nt - 2);
            const char* a1 = cA + (size_t)(t + 1) * kstep;
            const char* a2 = last ? nA : cA + (size_t)(t + 2) * kstep; const char* b2 = last ? nB : cB + (size_t)(t + 2) * kstep;
            const char* a3 = a2 + kstep; const char* b3 = b2 + kstep;
            PG8_LDB(B0, 0, 0); PG8_SCHED; PG8_LDA(At, 0, 0); PG8_STAGE(PG8_SA(1, 1), a1 + hstep, voffA);
            PG8_WAIT_L(8); PG8_BAR; PG8_WAIT_L(0); PG8_MMA(0, 0, At, B0); PG8_BAR; PG8_SCHED;
            PG8_LDB(B1, 0, 1); PG8_STAGE(PG8_SB(0, 0), b2, voffB);
            PG8_BAR; PG8_WAIT_L(0); PG8_MMA(0, 1, At, B1); PG8_BAR;
            PG8_LDA(At, 0, 1); PG8_STAGE(PG8_SA(0, 0), a2, voffA);
            PG8_BAR; PG8_WAIT_L(0); PG8_MMA(1, 0, At, B0); PG8_BAR; PG8_SCHED;
            PG8_STAGE(PG8_SB(0, 1), b2 + hstep, voffB);
            PG8_WAIT_V(6); PG8_BAR; PG8_MMA(1, 1, At, B1); PG8_BAR;
            PG8_LDB(B0, 1, 0); PG8_SCHED; PG8_LDA(At, 1, 0); PG8_STAGE(PG8_SA(0, 1), a2 + hstep, voffA);
            PG8_WAIT_L(8); PG8_BAR; PG8_WAIT_L(0); PG8_MMA(0, 0, At, B0); PG8_BAR; PG8_SCHED;
            PG8_LDB(B1, 1, 1); PG8_STAGE(PG8_SB(1, 0), b3, voffB);
            PG8_BAR; PG8_WAIT_L(0); PG8_MMA(0, 1, At, B1); PG8_BAR;
            PG8_LDA(At, 1, 1); PG8_STAGE(PG8_SA(1, 0), a3, voffA);
            PG8_BAR; PG8_WAIT_L(0); PG8_MMA(1, 0, At, B0); PG8_BAR; PG8_SCHED;
            PG8_STAGE(PG8_SB(1, 1), b3 + hstep, voffB);
            PG8_WAIT_V(6); PG8_BAR; PG8_MMA(1, 1, At, B1); PG8_BAR;
        }
        const bool zero = E(acc, cur, wr, wc, fr, fq);
        if (!has_next) break;
        if (zero) {
#pragma unroll
        for (int a = 0; a < 2; ++a)
#pragma unroll
            for (int b = 0; b < 2; ++b)
#pragma unroll
                for (int m = 0; m < 4; ++m)
#pragma unroll
                    for (int n = 0; n < 2; ++n) acc[a][b][m][n] = (f32x4){0.f, 0.f, 0.f, 0.f};
        }
        cur = nxt; cA = nA; cB = nB; ++ui;
    }
    PG8_WAIT_V(0);
    if (wr == 0) PG8_BAR;
    PG8_BAR;
#undef PG8_SA
#undef PG8_SB
#undef PG8_STAGE
#undef PG8_LDA
#undef PG8_LDB
#undef PG8_MMA
#undef PG8_WAIT_V
#undef PG8_WAIT_L
#undef PG8_BAR
#undef PG8_SCHED
}
}
using pg8::Unit;
constexpr size_t al256(size_t v) { return (v + 255) & ~(size_t)255; }
constexpr size_t O_CTR = 0, O_WTIN = 8192, O_WTGLU = O_WTIN + al256((size_t)DEPTH * INC * DM * 2), O_WTBR = O_WTGLU + al256((size_t)DEPTH * 512 * 512 * 2), O_WTOUT = O_WTBR + al256((size_t)DEPTH * 4 * 1024 * 512 * 2),
    O_WTKV = O_WTOUT + al256((size_t)DEPTH * DM * DM * 2), O_MEMH = O_WTKV + al256((size_t)DEPTH * DM * DM * 2), O_MK = O_MEMH + al256((size_t)2048 * DM * 2), O_MVT = O_MK + al256((size_t)DEPTH * 2048 * 512 * 2),
    O_DCOS = O_MVT + al256((size_t)DEPTH * 512 * 2048 * 2), O_DSIN = O_DCOS + al256((size_t)SEQ * 32 * 4), O_RCOS = O_DSIN + al256((size_t)SEQ * 32 * 4), O_RSIN = O_RCOS + al256((size_t)SEQ * 64 * 4),
    O_RCOST = O_RSIN + al256((size_t)SEQ * 64 * 4), O_RSINT = O_RCOST + al256((size_t)SEQ * 64 * 4), O_ABAR = O_RSINT + al256((size_t)SEQ * 64 * 4), O_BBAR = O_ABAR + al256((size_t)DEPTH * 32 * 64 * 2 * 4),
    O_CCT = O_BBAR + al256((size_t)DEPTH * 32 * 128 * 16 * 2), O_H = O_CCT + al256((size_t)DEPTH * 32 * 16 * 128 * 2), O_ZBUF = O_H + al256((size_t)TS * DM * 2), O_GATES = O_ZBUF + al256((size_t)TS * 512 * 2),
    O_PCB = O_GATES + al256((size_t)4 * TS * 1024 * 2), O_END = O_PCB + al256((size_t)13 * TS * 512 * 2);
struct WsView {
    char* b;
    DI unsigned* ctr() const { return (unsigned*)(b + O_CTR); }
    DI bf16_t* at(size_t o) const { return (bf16_t*)(b + o); }
    DI float* fat(size_t o) const { return (float*)(b + o); }
};
struct Params {
    const float *x, *mem, *norm_g, *w_in, *lam_re, *lam_im, *log_dt, *b_re, *b_im, *c_re, *c_im, *ssm_d, *w_glu, *b_glu;
    const float *dq_g, *dk_g, *lq1, *lk1, *lq2, *lk2, *hn_g, *mem_norm_g, *w_mem_kv, *mq_g, *mk_g, *w_branch, *b_merge, *w_out;
    float* out;
    char* wsb;
    DI const float* scal() const { char* b_ = wsb; asm volatile("" : "+s"(b_)); return (const float*)(__attribute__((address_space(1))) char*)(b_ + O_CTR + 4096); }
#define WSF(name, T, OFF) DI T* name##_() const { char* b_ = wsb; asm volatile("" : "+s"(b_)); return (T*)(__attribute__((address_space(1))) char*)(b_ + (OFF)); }
    WSF(ctr, unsigned, O_CTR) WSF(wt_in, bf16_t, O_WTIN) WSF(wt_glu, bf16_t, O_WTGLU) WSF(wt_br, bf16_t, O_WTBR) WSF(wt_out, bf16_t, O_WTOUT) WSF(wt_kv, bf16_t, O_WTKV) WSF(memh, bf16_t, O_MEMH)
    WSF(mk, bf16_t, O_MK) WSF(mvt, bf16_t, O_MVT) WSF(dcos, float, O_DCOS) WSF(dsin, float, O_DSIN) WSF(rcos, float, O_RCOS) WSF(rsin, float, O_RSIN) WSF(rcosT, float, O_RCOST) WSF(rsinT, float, O_RSINT)
    WSF(abar, float, O_ABAR) WSF(bbar, bf16_t, O_BBAR) WSF(cct, bf16_t, O_CCT) WSF(h, bf16_t, O_H) WSF(zbuf, bf16_t, O_ZBUF) WSF(gates, bf16_t, O_GATES) WSF(pcb, bf16_t, O_PCB)
#undef WSF
    DI bf16_t* pc(int i) const { return pcb_() + (size_t)i * TS * 512; }
    DI bf16_t* pt(int i) const { return pcb_() + (size_t)(i == 0 ? 12 : (i == 1 ? 4 : 8)) * TS * 512; }
};

#define FOR_ACC_PERM(...) \
    _Pragma("unroll") for (int ai = 0; ai < 2; ++ai) _Pragma("unroll") for (int m = 0; m < 4; ++m) { const int row = u.row0 + ai * 128 + wr * 64 + m * 16 + fr; \
    _Pragma("unroll") for (int bj = 0; bj < 2; ++bj) { const int col = u.col0 + bj * 128 + wc * 32 + 8 * fq; f32x4& v0 = acc[ai][bj][m][0]; f32x4& v1 = acc[ai][bj][m][1]; __VA_ARGS__ asm volatile("" ::: "memory"); } }

DI u32x4 pack8(const f32x4& v0, const f32x4& v1) { u32x4 w; w.x = pk2(v0[0], v0[1]); w.y = pk2(v0[2], v0[3]); w.z = pk2(v1[0], v1[1]); w.w = pk2(v1[2], v1[3]); return w; }
DI void unpack8(const u32x4 w, float (&f)[8]) { f[0] = lo2f(w.x); f[1] = hi2f(w.x); f[2] = lo2f(w.y); f[3] = hi2f(w.y); f[4] = lo2f(w.z); f[5] = hi2f(w.z); f[6] = lo2f(w.w); f[7] = hi2f(w.w); }

struct EpiIn {
    static constexpr bool PERM = true;
    Params p; int layer;
    DI bool operator()(f32x4 (&acc)[2][2][4][2], const Unit& u, int wr, int wc, int fr, int fq) const {
        const int v = u.aux;
        if (v >= 36) {
            bf16_t* dst = p.pt((v - 36) >> 1);
            FOR_ACC_PERM({ *(u32x4*)(dst + (size_t)row * TS + col) = pack8(v0, v1); })
        } else {
            const int ct = v < 8 ? v : (v < 14 ? v + 2 : v + 4);
            if (ct < 24) { bf16_t* dst = p.pc(ct >> 1);
                FOR_ACC_PERM({ *(u32x4*)(dst + (size_t)row * 512 + col) = pack8(v0, v1); })
            } else {
                const int d0 = u.col0 + 16 * wc + 4 * fq; const float* bm = p.b_merge + (size_t)layer * 4096 + d0;
                const f32x4 b0 = *(const f32x4*)(bm), b1 = *(const f32x4*)(bm + 1024), b2 = *(const f32x4*)(bm + 2048), b3 = *(const f32x4*)(bm + 3072);
                bf16_t* gp = p.gates_() + d0;
#pragma unroll
                for (int ai = 0; ai < 2; ++ai)
#pragma unroll
                    for (int m = 0; m < 4; ++m) { const size_t ro = (size_t)(u.row0 + ai * 128 + wr * 64 + m * 16 + fr) * 1024; f32x4 g0, g1, g2, g3;
#pragma unroll
                        for (int j = 0; j < 4; ++j) { g0[j] = sigmoidf_(fminf(fmaxf(acc[ai][0][m][0][j] + b0[j], -30.f), 30.f)); g1[j] = sigmoidf_(fminf(fmaxf(acc[ai][0][m][1][j] + b1[j], -30.f), 30.f));
                            g2[j] = sigmoidf_(fminf(fmaxf(acc[ai][1][m][0][j] + b2[j], -30.f), 30.f)); g3[j] = sigmoidf_(fminf(fmaxf(acc[ai][1][m][1][j] + b3[j], -30.f), 30.f)); }
                        u32x2 w0, w1, w2, w3;
                        w0.x = pk2(g0[0] / g1[0], g0[1] / g1[1]); w0.y = pk2(g0[2] / g1[2], g0[3] / g1[3]); w1.x = pk2(g1[0] / g2[0], g1[1] / g2[1]); w1.y = pk2(g1[2] / g2[2], g1[3] / g2[3]);
                        w2.x = pk2(g2[0] / g3[0], g2[1] / g3[1]); w2.y = pk2(g2[2] / g3[2], g2[3] / g3[3]); w3.x = pk2(g3[0], g3[1]); w3.y = pk2(g3[2], g3[3]);
                        *(u32x2*)(gp + ro) = w0; *(u32x2*)(gp + (size_t)TS * 1024 + ro) = w1; *(u32x2*)(gp + (size_t)2 * TS * 1024 + ro) = w2; *(u32x2*)(gp + (size_t)3 * TS * 1024 + ro) = w3; }
            }
        }
        return true;
    }
};
struct SchedIn {
    Params p; int layer, G, c;
    DI bool next(int i, Unit& u) const {
        const int L = i * G + c; if (L >= (TS / 256) * 42) return false;
        int pm, pn; pg8::tile_of(L, TS / 256, 42, pm, pn);
        const char* W = (const char*)(p.wt_in_() + (size_t)layer * INC * DM); const char* H = (const char*)p.h_();
        u.aux = pn;
        if (pn < 36) { const int ct = pn < 8 ? pn : (pn < 14 ? pn + 2 : pn + 4);
            u.A = H + (size_t)pm * 256 * DM * 2; u.B = W + (size_t)ct * 256 * DM * 2; u.row0 = pm * 256; u.col0 = ct < 24 ? (ct & 1) * 256 : (ct - 24) * 64;
        } else { const int sv = pn - 36; const int piece = sv < 2 ? 3 : (sv < 4 ? 4 : 8);
            u.A = W + (size_t)(piece * 512 + (sv & 1) * 256) * DM * 2; u.B = H + (size_t)pm * 256 * DM * 2; u.row0 = (sv & 1) * 256; u.col0 = pm * 256; }
        return true;
    }
};
struct EpiKV {
    static constexpr bool PERM = true;
    Params p;
    DI bool operator()(f32x4 (&acc)[2][2][4][2], const Unit& u, int wr, int wc, int fr, int fq) const {
        const int layer = u.aux >> 1, sw = u.aux & 1;
        if (sw) { bf16_t* dst = p.mvt_() + (size_t)layer * 512 * 2048; FOR_ACC_PERM({ *(u32x4*)(dst + (size_t)row * 2048 + col) = pack8(v0, v1); }) }
        else { bf16_t* dst = p.mk_() + (size_t)layer * 2048 * 512; FOR_ACC_PERM({ *(u32x4*)(dst + (size_t)row * 512 + col) = pack8(v0, v1); }) }
        return true;
    }
};
struct SchedKV {
    Params p; int G, c;
    DI bool next(int i, Unit& u) const {
        const int L = i * G + c; if (L >= 8 * 8) return false;
        const int pm = L & 7, q = L >> 3, layer = q >> 2, t = q & 3;
        const char* W = (const char*)(p.wt_kv_() + (size_t)layer * 1024 * 1024); const char* H = (const char*)p.memh_();
        if (t < 2) { u.A = H + (size_t)pm * 256 * DM * 2; u.B = W + (size_t)t * 256 * DM * 2; u.row0 = pm * 256; u.col0 = t * 256; u.aux = layer * 2; }
        else { u.A = W + (size_t)(512 + (t - 2) * 256) * DM * 2; u.B = H + (size_t)pm * 256 * DM * 2; u.row0 = (t - 2) * 256; u.col0 = pm * 256; u.aux = layer * 2 + 1; }
        return true;
    }
};
struct EpiGlu {
    static constexpr bool PERM = true;
    Params p; int layer;
    DI bool operator()(f32x4 (&acc)[2][2][4][2], const Unit& u, int wr, int wc, int fr, int fq) const {
        const float* bg = p.b_glu + (size_t)layer * 512;
        FOR_ACC_PERM({ const f32x4 b0 = *(const f32x4*)(bg + col), b1 = *(const f32x4*)(bg + col + 4);
            float z[8], g[8]; unpack8(*(const u32x4*)(p.zbuf_() + (size_t)row * 512 + col), z); unpack8(*(const u32x4*)(p.pc(1) + (size_t)row * 512 + col), g);
            f32x4 o0, o1;
            _Pragma("unroll") for (int j = 0; j < 4; ++j) { o0[j] = z[j] * sigmoidf_(v0[j] + b0[j]) * siluf_(g[j]); o1[j] = z[4 + j] * sigmoidf_(v1[j] + b1[j]) * siluf_(g[4 + j]); }
            *(u32x4*)(p.pc(1) + (size_t)row * 512 + col) = pack8(o0, o1); })
        return true;
    }
};
struct SchedGlu {
    Params p; int layer, G, c;
    DI bool next(int i, Unit& u) const {
        const int L = i * G + c; if (L >= (TS / 256) * 2) return false;
        const int pm = L >> 1, pn = L & 1;
        u.A = (const char*)(p.zbuf_() + (size_t)pm * 256 * 512); u.B = (const char*)(p.wt_glu_() + (size_t)layer * 512 * 512 + (size_t)pn * 256 * 512); u.row0 = pm * 256; u.col0 = pn * 256; u.aux = 0;
        return true;
    }
};
struct EpiMerge {
    static constexpr bool PERM = true;
    const bf16_t* gates; bf16_t* merged;
    DI bool operator()(f32x4 (&acc)[2][2][4][2], const Unit& u, int wr, int wc, int fr, int fq) const {
        const int n = u.aux; const bool lastn = (n == 3); const bf16_t* g0p = gates + (size_t)n * TS * 1024;
        FOR_ACC_PERM({ float a[8]; unpack8(*(const u32x4*)(g0p + (size_t)row * 1024 + col), a);
            _Pragma("unroll") for (int j = 0; j < 4; ++j) { v0[j] *= a[j]; v1[j] *= a[4 + j]; }
            if (lastn) { *(u32x4*)(merged + (size_t)row * 1024 + col) = pack8(v0, v1); v0 = (f32x4){0.f, 0.f, 0.f, 0.f}; v1 = (f32x4){0.f, 0.f, 0.f, 0.f}; } })
        return false;
    }
};
struct SchedMerge {
    Params p; int layer, G, c;
    DI bool next(int i, Unit& u) const {
        const int ti = i >> 2, n = i & 3; const int L = ti * G + c; if (L >= (TS / 256) * 4) return false;
        int pm, pn; pg8::tile_of(L, TS / 256, 4, pm, pn);
        const bf16_t* A = n == 0 ? p.pc(1) : (n == 1 ? p.pc(5) : (n == 2 ? p.pc(9) : p.pc(11)));
        u.A = (const char*)(A + (size_t)pm * 256 * 512); u.B = (const char*)(p.wt_br_() + ((size_t)(layer * 4 + n) * 1024 + (size_t)pn * 256) * 512); u.row0 = pm * 256; u.col0 = pn * 256; u.aux = n;
        return true;
    }
};
struct EpiOut {
    static constexpr bool PERM = false;
    const float* xin; float* xout;
    DI bool operator()(f32x4 (&acc)[2][2][4][2], const Unit& u, int wr, int wc, int fr, int fq) const {
#pragma unroll
        for (int ai = 0; ai < 2; ++ai)
#pragma unroll
            for (int m = 0; m < 4; ++m) { const size_t ro = (size_t)(u.row0 + ai * 128 + wr * 64 + m * 16 + fr) * 1024 + u.col0 + wc * 32 + 4 * fq;
#pragma unroll
                for (int bj = 0; bj < 2; ++bj)
#pragma unroll
                    for (int n = 0; n < 2; ++n) { const size_t o = ro + bj * 128 + n * 16; *(f32x4*)(xout + o) = *(const f32x4*)(xin + o) + acc[ai][bj][m][n]; } }
        return true;
    }
};
struct SchedOut {
    Params p; int layer, G, c;
    DI bool next(int i, Unit& u) const {
        const int L = i * G + c; if (L >= (TS / 256) * 4) return false;
        int pm, pn; pg8::tile_of(L, TS / 256, 4, pm, pn);
        u.A = (const char*)(p.h_() + (size_t)pm * 256 * 1024); u.B = (const char*)(p.wt_out_() + ((size_t)layer * 1024 + (size_t)pn * 256) * 1024); u.row0 = pm * 256; u.col0 = pn * 256; u.aux = 0;
        return true;
    }
};
DI int win_row(int cidx) {
    if (cidx < 6144) return cidx; const int n = (cidx - 6144) >> 10, d = (cidx - 6144) & 1023, tile = d >> 6, dd = d & 63;
    return 6144 + tile * 256 + 128 * (n >> 1) + 32 * (dd >> 4) + 8 * ((dd & 15) >> 2) + 4 * (n & 1) + (dd & 3); }
template <bool WIN>
DI void transpose_job(LAS float* tl, const float* src, bf16_t* dst, int R, int C, const float* scale, int& tctr) {
    const int ntr = R / 64, ntc = C / 64, nt = ntr * ntc; const int tid_ = opaque_tid(); const int tx = tid_ & 63, ty = tid_ >> 6;
    for (int t = 0; t < nt; ++t, ++tctr) {
        if ((tctr % (int)gridDim.x) != (int)blockIdx.x) continue;
        const int tr = t / ntc, tc = t % ntc;
        __syncthreads();
#pragma unroll
        for (int i = 0; i < 8; ++i) { const int r = ty + 8 * i; float v = src[(size_t)(tr * 64 + r) * C + tc * 64 + tx]; if (scale) v *= scale[tr * 64 + r]; tl[r * 65 + tx] = v; }
        __syncthreads();
#pragma unroll
        for (int i = 0; i < 8; ++i) { const int cc = ty + 8 * i; const int drow = WIN ? win_row(tc * 64 + cc) : tc * 64 + cc; dst[(size_t)drow * R + tr * 64 + tx] = f2bf(tl[tx * 65 + cc]); }
    }
}

DI void phase_prep(const Params& p, LAS unsigned char* lds) {
    LAS float* tl = (LAS float*)lds; int tctr = 0;
    for (int l = 0; l < DEPTH; ++l) {
        transpose_job<true>(tl, p.w_in + (size_t)l * DM * INC, p.wt_in_() + (size_t)l * INC * DM, DM, INC, p.norm_g + l * DM, tctr);
        transpose_job<false>(tl, p.w_glu + (size_t)l * 512 * 512, p.wt_glu_() + (size_t)l * 512 * 512, 512, 512, nullptr, tctr);
        for (int n = 0; n < 4; ++n) transpose_job<false>(tl, p.w_branch + (size_t)(l * 4 + n) * 512 * 1024, p.wt_br_() + (size_t)(l * 4 + n) * 1024 * 512, 512, 1024, nullptr, tctr);
        transpose_job<false>(tl, p.w_out + (size_t)l * DM * DM, p.wt_out_() + (size_t)l * DM * DM, DM, DM, nullptr, tctr);
        transpose_job<false>(tl, p.w_mem_kv + (size_t)l * DM * DM, p.wt_kv_() + (size_t)l * DM * DM, DM, DM, p.mem_norm_g + l * DM, tctr);
    }
    const long gtid = (long)blockIdx.x * 512 + opaque_tid(), gn = (long)gridDim.x * 512;
    for (long i = gtid; i < (long)SEQ * 32; i += gn) { const int pos = (int)(i >> 5), d = (int)(i & 31);
        const float inv = (float)exp(-(double)(2 * d) / 64.0 * 9.210340371976184); const float ang = (float)pos * inv; float s, c; sincosf(ang, &s, &c); p.dcos_()[i] = c; p.dsin_()[i] = s; }
    for (long i = gtid; i < (long)SEQ * 64; i += gn) { const int pos = (int)(i >> 6), d = (int)(i & 63);
        const float lin = (float)d / 63.0f; const float inv = 1.0f / (float)exp((double)lin * 9.210340371976184); const float ang = (float)pos * inv; float s, c; sincosf(ang, &s, &c);
        p.rcos_()[i] = c; p.rsin_()[i] = s; p.rcosT_()[(size_t)d * SEQ + pos] = c; p.rsinT_()[(size_t)d * SEQ + pos] = s; }
    for (long i = gtid; i < (long)DEPTH * 32 * 64; i += gn) { const int pp = (int)(i & 63), g = (int)((i >> 6) & 31), l = (int)(i >> 11);
        const float lr = fminf(p.lam_re[i], -1e-4f), li = p.lam_im[i], dt = expf(p.log_dt[l * 32 + g]);
        const float mag = expf(lr * dt); float sn, cs; sincosf(li * dt, &sn, &cs); const float are = mag * cs, aim = mag * sn;
        const float nr = are - 1.0f, ni = aim, den = lr * lr + li * li; const float fre = (nr * lr + ni * li) / den, fim = (ni * lr - nr * li) / den;
        p.abar_()[i * 2] = are; p.abar_()[i * 2 + 1] = aim;
        bf16_t* bb = p.bbar_() + ((size_t)(l * 32 + g) * 128) * 16; const float* br = p.b_re + i * 16; const float* bi = p.b_im + i * 16;
        for (int hch = 0; hch < 16; ++hch) { bb[(size_t)pp * 16 + hch] = f2bf(fre * br[hch] - fim * bi[hch]); bb[(size_t)(64 + pp) * 16 + hch] = f2bf(fre * bi[hch] + fim * br[hch]); }
        bf16_t* cc = p.cct_() + ((size_t)(l * 32 + g) * 16) * 128;
        for (int hch = 0; hch < 16; ++hch) { const size_t ci = ((size_t)(l * 32 + g) * 16 + hch) * 64 + pp; cc[hch * 128 + pp] = f2bf(p.c_re[ci]); cc[hch * 128 + 64 + pp] = f2bf(-p.c_im[ci]); }
    }
    if (blockIdx.x == 0 && threadIdx.x < 64) { const int lane = threadIdx.x; float* sc = (float*)(p.wsb + O_CTR + 4096);
        for (int l = 0; l < DEPTH; ++l) { const float lam_init = l == 0 ? 0.2f : 0.35550906759096926f;
            float s1 = p.lq1[l * 64 + lane] * p.lk1[l * 64 + lane], s2 = p.lq2[l * 64 + lane] * p.lk2[l * 64 + lane]; s1 = wave_sum(s1); s2 = wave_sum(s2);
            const float mdq = wave_max(fabsf(p.dq_g[l * 64 + lane])), mdk = wave_max(fabsf(p.dk_g[l * 64 + lane]));
            const float mmq = wave_max(fmaxf(fabsf(p.mq_g[l * 128 + lane]), fabsf(p.mq_g[l * 128 + 64 + lane]))), mmk = wave_max(fmaxf(fabsf(p.mk_g[l * 128 + lane]), fabsf(p.mk_g[l * 128 + 64 + lane])));
            if (lane == 0) { sc[l * 8] = expf(s1) - expf(s2) + lam_init; sc[l * 8 + 1] = -8.0f * mdq * mdk * 1.4426950408889634f; sc[l * 8 + 2] = -11.313708498984761f * mmq * mmk * 1.4426950408889634f; } } }
    { const int tid_ = opaque_tid(); const int wv = (blockIdx.x * 8 + (tid_ >> 6)), nwv = gridDim.x * 8, lane = tid_ & 63;
      for (int r = wv; r < NBATCH * MEML; r += nwv) { const float* s = p.mem + (size_t)r * DM; f32x4 v[4]; float ss = 0.f;
#pragma unroll
          for (int i = 0; i < 4; ++i) { v[i] = *(const f32x4*)(s + i * 256 + lane * 4); ss += v[i][0] * v[i][0] + v[i][1] * v[i][1] + v[i][2] * v[i][2] + v[i][3] * v[i][3]; }
          ss = wave_sum(ss); const float rs = rsqrtf(ss * (1.0f / DM) + EPSN);
#pragma unroll
          for (int i = 0; i < 4; ++i) { u32x2 w; w.x = pk2(v[i][0] * rs, v[i][1] * rs); w.y = pk2(v[i][2] * rs, v[i][3] * rs); *(u32x2*)(p.memh_() + (size_t)r * DM + i * 256 + lane * 4) = w; } } }
}

DI void phase_norm(const Params& p, const float* xs) {
    const int tid_ = opaque_tid(); const int wv = (blockIdx.x * 8 + (tid_ >> 6)), nwv = gridDim.x * 8, lane = tid_ & 63;
    for (int r = wv; r < TS; r += nwv) { const float* s = xs + (size_t)r * DM; f32x4 v[4]; float ss = 0.f;
#pragma unroll
        for (int i = 0; i < 4; ++i) { v[i] = *(const f32x4*)(s + i * 256 + lane * 4); ss += v[i][0] * v[i][0] + v[i][1] * v[i][1] + v[i][2] * v[i][2] + v[i][3] * v[i][3]; }
        ss = wave_sum(ss); const float rs = rsqrtf(ss * (1.0f / DM) + EPSN);
#pragma unroll
        for (int i = 0; i < 4; ++i) { u32x2 w; w.x = pk2(v[i][0] * rs, v[i][1] * rs); w.y = pk2(v[i][2] * rs, v[i][3] * rs); *(u32x2*)(p.h_() + (size_t)r * DM + i * 256 + lane * 4) = w; } }
}
DI void phase_mknorm(const Params& p) {
    const long gtid = (long)blockIdx.x * 512 + opaque_tid(), gn = (long)gridDim.x * 512;
    for (long i = gtid; i < (long)DEPTH * 2048 * 4 * 16; i += gn) { const int sub = (int)(i & 15); const long rh = i >> 4; const int hd = (int)(rh & 3); const long row = rh >> 2; const int l = (int)(row / 2048);
        bf16_t* ptr = p.mk_() + (size_t)row * 512 + hd * 128 + sub * 8; float f[8]; unpack8(*(const u32x4*)ptr, f); float ss = 0.f;
#pragma unroll
        for (int j = 0; j < 8; ++j) ss += f[j] * f[j];
        ss += shx(ss, 1); ss += shx(ss, 2); ss += shx(ss, 4); ss += shx(ss, 8);
        const float rs = rsqrtf(ss * (1.0f / 128.0f) + EPSN); const float* g = p.mk_g + l * 128 + sub * 8; f32x4 o0, o1;
#pragma unroll
        for (int j = 0; j < 4; ++j) { o0[j] = f[j] * rs * g[j]; o1[j] = f[4 + j] * rs * g[4 + j]; }
        *(u32x4*)ptr = pack8(o0, o1); }
}
DI void phase_rope(const Params& p, int layer) {
    const long gtid = (long)blockIdx.x * 512 + opaque_tid(), gn = (long)gridDim.x * 512;
    for (long i = gtid; i < (long)TS * 32; i += gn) { const int dg = (int)(i & 7), hd = (int)((i >> 3) & 3); const long t = i >> 5; const int pos = (int)(t & (SEQ - 1));
        const f32x4 c0 = *(const f32x4*)(p.rcos_() + (size_t)pos * 64 + dg * 8), c1 = *(const f32x4*)(p.rcos_() + (size_t)pos * 64 + dg * 8 + 4);
        const f32x4 s0 = *(const f32x4*)(p.rsin_() + (size_t)pos * 64 + dg * 8), s1 = *(const f32x4*)(p.rsin_() + (size_t)pos * 64 + dg * 8 + 4);
#pragma unroll
        for (int which = 0; which < 2; ++which) { bf16_t* base = p.pc(2 + which) + (size_t)t * 512 + hd * 128 + dg * 8; const float sc = which ? 0.08838834764831845f : 1.0f;
            float a[8], b[8]; unpack8(*(const u32x4*)base, a); unpack8(*(const u32x4*)(base + 64), b); f32x4 o0, o1, q0, q1;
#pragma unroll
            for (int j = 0; j < 4; ++j) { o0[j] = (a[j] * c0[j] - b[j] * s0[j]) * sc; q0[j] = (b[j] * c0[j] + a[j] * s0[j]) * sc; o1[j] = (a[4 + j] * c1[j] - b[4 + j] * s1[j]) * sc; q1[j] = (b[4 + j] * c1[j] + a[4 + j] * s1[j]) * sc; }
            *(u32x4*)base = pack8(o0, o1); *(u32x4*)(base + 64) = pack8(q0, q1); } }
    for (long i = gtid; i < (long)4 * 64 * (TS / 8); i += gn) { const long tg = i % (TS / 8); const int d = (int)((i / (TS / 8)) & 63), hd = (int)(i / ((long)(TS / 8) * 64));
        const long t0 = tg * 8; const int pos0 = (int)(t0 & (SEQ - 1));
        const f32x4 c0 = *(const f32x4*)(p.rcosT_() + (size_t)d * SEQ + pos0), c1 = *(const f32x4*)(p.rcosT_() + (size_t)d * SEQ + pos0 + 4);
        const f32x4 s0 = *(const f32x4*)(p.rsinT_() + (size_t)d * SEQ + pos0), s1 = *(const f32x4*)(p.rsinT_() + (size_t)d * SEQ + pos0 + 4);
        const float lg2 = log2f(1.0f - exp2f(-5.0f - (float)hd)); bf16_t* base = p.pt(0) + (size_t)(hd * 128 + d) * TS + t0;
        float a[8], b[8]; unpack8(*(const u32x4*)base, a); unpack8(*(const u32x4*)(base + (size_t)64 * TS), b); f32x4 o0, o1, q0, q1;
#pragma unroll
        for (int j = 0; j < 4; ++j) { const float k0 = 0.08838834764831845f * exp2f(lg2 * (float)(63 - ((pos0 + j) & 63))), k1 = 0.08838834764831845f * exp2f(lg2 * (float)(63 - ((pos0 + 4 + j) & 63)));
            o0[j] = (a[j] * c0[j] - b[j] * s0[j]) * k0; q0[j] = (b[j] * c0[j] + a[j] * s0[j]) * k0; o1[j] = (a[4 + j] * c1[j] - b[4 + j] * s1[j]) * k1; q1[j] = (b[4 + j] * c1[j] + a[4 + j] * s1[j]) * k1; }
        *(u32x4*)base = pack8(o0, o1); *(u32x4*)(base + (size_t)64 * TS) = pack8(q0, q1); }
    for (long i = gtid; i < (long)TS * 8 * 2 * 4; i += gn) { const int sub = (int)(i & 3); const long r = i >> 2; const int which = (int)(r & 1); const long r2 = r >> 1; const int un = (int)(r2 & 7); const long t = r2 >> 3; const int pos = (int)(t & (SEQ - 1));
        bf16_t* base = p.pc(6 + which) + (size_t)t * 512 + un * 64 + sub * 8; const float* g = (which ? p.dk_g : p.dq_g) + layer * 64 + sub * 8;
        float a[8], b[8]; unpack8(*(const u32x4*)base, a); unpack8(*(const u32x4*)(base + 32), b); float ss = 0.f;
#pragma unroll
        for (int j = 0; j < 8; ++j) ss += a[j] * a[j] + b[j] * b[j];
        ss += shx(ss, 1); ss += shx(ss, 2); const float rs = rsqrtf(ss * (1.0f / 64.0f) + EPSN) * (which ? 1.0f : 0.125f);
        const f32x4 c0 = *(const f32x4*)(p.dcos_() + (size_t)pos * 32 + sub * 8), c1 = *(const f32x4*)(p.dcos_() + (size_t)pos * 32 + sub * 8 + 4);
        const f32x4 s0 = *(const f32x4*)(p.dsin_() + (size_t)pos * 32 + sub * 8), s1 = *(const f32x4*)(p.dsin_() + (size_t)pos * 32 + sub * 8 + 4);
        f32x4 o0, o1, q0, q1;
#pragma unroll
        for (int j = 0; j < 4; ++j) { const float x0 = a[j] * rs * g[j], y0 = b[j] * rs * g[32 + j], x1 = a[4 + j] * rs * g[4 + j], y1 = b[4 + j] * rs * g[36 + j];
            o0[j] = x0 * c0[j] - y0 * s0[j]; q0[j] = y0 * c0[j] + x0 * s0[j]; o1[j] = x1 * c1[j] - y1 * s1[j]; q1[j] = y1 * c1[j] + x1 * s1[j]; }
        *(u32x4*)base = pack8(o0, o1); *(u32x4*)(base + 32) = pack8(q0, q1); }
}
#define MFMA32(a, b, c) __builtin_amdgcn_mfma_f32_32x32x16_bf16((a), (b), (c), 0, 0, 0)
#define MFMA16(a, b, c) __builtin_amdgcn_mfma_f32_16x16x32_bf16((a), (b), (c), 0, 0, 0)
DI int pi32(int r) { return (r & ~12) | ((r & 4) << 1) | ((r & 8) >> 1); }
DI int crow(int reg, int h) { return (reg & 3) + 8 * (reg >> 2) + 4 * h; }
DI bf16x8 pack_regs(const f32x16& x, int s) { u32x4 w; w.x = pk2(x[8 * s], x[8 * s + 1]); w.y = pk2(x[8 * s + 2], x[8 * s + 3]); w.z = pk2(x[8 * s + 4], x[8 * s + 5]); w.w = pk2(x[8 * s + 6], x[8 * s + 7]); return __builtin_bit_cast(bf16x8, w); }
DI void glds16(const void* g, LAS unsigned char* l) { __builtin_amdgcn_global_load_lds((const unsigned*)g, (LAS unsigned*)l, 16, 0, 0); }

template <int NMAP>
DI void attn_item(LAS unsigned char* lds, const bf16_t* Qr, const float* qg, const bf16_t* Kg, int ldk, const bf16_t* Vtg, int ldv,
                  int ntiles, int wnt_base, float nshift, bf16_t* gate, const float* hn_g, float lam, float oscale) {
    constexpr int DHM = 128 / NMAP, NKS = DHM / 16;
    const int tid = opaque_tid(), w = __builtin_amdgcn_readfirstlane(tid >> 6), lane = tid & 63, r = lane & 31, h = lane >> 5;
    const int wnt = wnt_base + (NMAP == 2 ? (w >> 1) : 0);
    bf16x8 qf[NMAP][NKS];
    { const bf16_t* qrow = Qr + (size_t)(32 * w + r) * 512;
#pragma unroll
      for (int m = 0; m < NMAP; ++m)
#pragma unroll
          for (int ks = 0; ks < NKS; ++ks) qf[m][ks] = *(const bf16x8*)(qrow + m * DHM + 16 * ks + 8 * h);
      if (NMAP == 1) { float ss = 0.f;
#pragma unroll
          for (int ks = 0; ks < NKS; ++ks) { float f[8]; unpack8(__builtin_bit_cast(u32x4, qf[0][ks]), f);
#pragma unroll
              for (int j = 0; j < 8; ++j) ss += f[j] * f[j]; }
          ss += shx(ss, 32); const float rs = rsqrtf(ss * (1.0f / 128.0f) + EPSN) * 0.08838834764831845f;
#pragma unroll
          for (int ks = 0; ks < NKS; ++ks) { float f[8]; unpack8(__builtin_bit_cast(u32x4, qf[0][ks]), f); const float* g = qg + 16 * ks + 8 * h; f32x4 a, b;
#pragma unroll
              for (int j = 0; j < 4; ++j) { a[j] = f[j] * rs * g[j]; b[j] = f[4 + j] * rs * g[4 + j]; }
              qf[0][ks] = __builtin_bit_cast(bf16x8, pack8(a, b)); } } }
    LAS unsigned char* q1l = lds + 65536 + w * 4096 + lane * 16;
    if (NMAP == 2) {
#pragma unroll
        for (int ks = 0; ks < NKS; ++ks) *(LAS bf16x8*)(q1l + ks * 1024) = qf[NMAP - 1][ks];
    }
    f32x16 o[NMAP][4]; float l[NMAP];
#pragma unroll
    for (int m = 0; m < NMAP; ++m) { l[m] = 0.f;
#pragma unroll
        for (int d = 0; d < 4; ++d)
#pragma unroll
            for (int i = 0; i < 16; ++i) o[m][d][i] = 0.f; }
    unsigned ksrc[2], vsrc[2];
#pragma unroll
    for (int i = 0; i < 2; ++i) { const int slot = 2 * w + i; const int kr = 4 * slot + (lane >> 4), kc = (lane & 15) ^ (kr & 15); ksrc[i] = (unsigned)(kr * ldk * 2 + kc * 16);
        const int vr = 8 * slot + (lane >> 3), vc = (lane & 7) ^ ((vr >> 1) & 7); vsrc[i] = (unsigned)(vr * ldv * 2 + vc * 16); }
    const char* kgb = (const char*)Kg; const char* vgb = (const char*)Vtg;
#define ATT_STAGE(kt, buf) do { const char* kp_ = kgb + (size_t)(kt) * 64 * ldk * 2; const char* vp_ = vgb + (size_t)(kt) * 128; \
        _Pragma("unroll") for (int i_ = 0; i_ < 2; ++i_) { glds16(kp_ + ksrc[i_], lds + (buf) * 16384 + (2 * w + i_) * 1024); glds16(vp_ + vsrc[i_], lds + 32768 + (buf) * 16384 + (2 * w + i_) * 1024); } } while (0)
    const int pr = pi32(r); const unsigned kbase = (unsigned)pr * 256u, kx = (unsigned)((pr & 15) ^ h) << 4;
    const unsigned vbase = (unsigned)r * 128u, vx = (unsigned)(((r >> 1) & 7) ^ h) << 4;
    ATT_STAGE(0, 0);
    for (int kt = 0; kt < ntiles; ++kt) {
        asm volatile("s_waitcnt vmcnt(0)" ::: "memory"); __builtin_amdgcn_s_barrier(); asm volatile("" ::: "memory");
        if (kt + 1 < ntiles) ATT_STAGE(kt + 1, (kt + 1) & 1);
        if (kt < wnt) {
            LAS unsigned char* kb = lds + (kt & 1) * 16384; LAS unsigned char* vb = lds + 32768 + (kt & 1) * 16384;
#pragma unroll 1
            for (int kb2 = 0; kb2 < 2; ++kb2) {
                bf16x8 pf[NMAP][2];
#pragma unroll
                for (int m = 0; m < NMAP; ++m) {
                    f32x16 s;
#pragma unroll
                    for (int i = 0; i < 16; ++i) s[i] = 0.f;
#pragma unroll
                    for (int ks = 0; ks < NKS; ++ks) { const unsigned c = (unsigned)(m * (DHM / 8) + 2 * ks) << 4;
                        const bf16x8 a = *(const LAS bf16x8*)(kb + kb2 * 8192 + kbase + (kx ^ c)); const bf16x8 qb_ = (NMAP == 2 && m == 1) ? *(const LAS bf16x8*)(q1l + ks * 1024) : qf[0][ks]; s = MFMA32(a, qb_, s); }
#pragma unroll
                    for (int i = 0; i < 16; ++i) { const float pv = __builtin_amdgcn_exp2f(fmaf(s[i], 1.4426950408889634f, nshift)); s[i] = pv; l[m] += pv; }
                    pf[m][0] = pack_regs(s, 0); pf[m][1] = pack_regs(s, 1);
                }
#pragma unroll
                for (int s2 = 0; s2 < 2; ++s2) { const unsigned c = (unsigned)(4 * kb2 + 2 * s2) << 4;
#pragma unroll
                    for (int d = 0; d < 4; ++d) { const bf16x8 a = *(const LAS bf16x8*)(vb + d * 4096 + vbase + (vx ^ c));
#pragma unroll
                        for (int m = 0; m < NMAP; ++m) o[m][d] = MFMA32(a, pf[m][s2], o[m][d]); } }
            }
        }
    }
#undef ATT_STAGE
    float inv[NMAP];
#pragma unroll
    for (int m = 0; m < NMAP; ++m) { l[m] += shx(l[m], 32); inv[m] = 1.0f / l[m]; }
    float rs; { int ob = __float_as_int(oscale); asm volatile("" : "+s"(ob)); rs = __int_as_float(ob); }
    if (NMAP == 2) { float ss = 0.f;
#pragma unroll
        for (int d = 0; d < 4; ++d)
#pragma unroll
            for (int i = 0; i < 16; ++i) { const float v = o[0][d][i] * inv[0] - lam * o[NMAP - 1][d][i] * inv[NMAP - 1]; o[0][d][i] = v; ss += v * v; }
        ss += shx(ss, 32); rs *= rsqrtf(ss * (1.0f / 128.0f) + EPSN);
    } else {
#pragma unroll
        for (int d = 0; d < 4; ++d)
#pragma unroll
            for (int i = 0; i < 16; ++i) o[0][d][i] *= inv[0];
    }
    const int tid2 = opaque_tid(); bf16_t* grow = gate + (size_t)(32 * (tid2 >> 6) + (tid2 & 31)) * 512;
#pragma unroll
    for (int d = 0; d < 4; ++d)
#pragma unroll
        for (int gq = 0; gq < 4; ++gq) { const int dv = 32 * d + 8 * gq + 4 * h; const u32x2 gw = *(const u32x2*)(grow + dv);
            const float g0 = lo2f(gw.x), g1 = hi2f(gw.x), g2 = lo2f(gw.y), g3 = hi2f(gw.y); float e0 = rs, e1 = rs, e2 = rs, e3 = rs;
            if (NMAP == 2) { const f32x4 hg = *(const f32x4*)(hn_g + dv); e0 *= hg[0]; e1 *= hg[1]; e2 *= hg[2]; e3 *= hg[3]; }
            u32x2 ow; ow.x = pk2(o[0][d][4 * gq] * e0 * siluf_(g0), o[0][d][4 * gq + 1] * e1 * siluf_(g1)); ow.y = pk2(o[0][d][4 * gq + 2] * e2 * siluf_(g2), o[0][d][4 * gq + 3] * e3 * siluf_(g3));
            *(u32x2*)(grow + dv) = ow; }
    __builtin_amdgcn_s_barrier();
}
DI void ret_item(LAS unsigned char* lds, const bf16_t* Qg, const bf16_t* Kg, const bf16_t* Ktg, const bf16_t* Vtg, bf16_t* gate, int hd) {
    const int tid = opaque_tid(), w = __builtin_amdgcn_readfirstlane(tid >> 6), lane = tid & 63, r = lane & 31, h = lane >> 5;
    const float lg2 = log2f(1.0f - exp2f(-5.0f - (float)hd)); const float cdec = exp2f(64.0f * lg2);
    size_t qsrc[2], tsrc[2];
#pragma unroll
    for (int i = 0; i < 2; ++i) { const int slot = 2 * w + i; const int kr = 4 * slot + (lane >> 4), kc = (lane & 15) ^ (kr & 15); qsrc[i] = (size_t)kr * 1024 + kc * 16;
        const int vr = 8 * slot + (lane >> 3), vc = (lane & 7) ^ ((vr >> 1) & 7); tsrc[i] = (size_t)vr * TS * 2 + vc * 16; }
#define RET_STAGE(c, buf) do { const size_t qo = (size_t)(c) * 64 * 1024, to = (size_t)(c) * 128; LAS unsigned char* bb = lds + (buf) * 65536; \
        _Pragma("unroll") for (int i_ = 0; i_ < 2; ++i_) { const int so = (2 * w + i_) * 1024; glds16((const char*)Qg + qo + qsrc[i_], bb + so); glds16((const char*)Kg + qo + qsrc[i_], bb + 16384 + so); \
            glds16((const char*)Ktg + to + tsrc[i_], bb + 32768 + so); glds16((const char*)Vtg + to + tsrc[i_], bb + 49152 + so); } } while (0)
    LAS unsigned char* pimg = lds + 131072; LAS float* red = (LAS float*)(lds + 131072 + 8192);
    f32x16 S[4];
#pragma unroll
    for (int d = 0; d < 4; ++d)
#pragma unroll
        for (int i = 0; i < 16; ++i) S[d][i] = 0.f;
    const int pr = pi32(r);
    const unsigned x16 = (unsigned)((r & 15) ^ h) << 4, x16p = (unsigned)((pr & 15) ^ h) << 4, x8 = (unsigned)(((r >> 1) & 7) ^ h) << 4;
    RET_STAGE(0, 0);
    for (int c = 0; c < SEQ / 64; ++c) {
        asm volatile("s_waitcnt vmcnt(0)" ::: "memory"); __builtin_amdgcn_s_barrier(); asm volatile("" ::: "memory");
        if (c + 1 < SEQ / 64) RET_STAGE(c + 1, (c + 1) & 1);
        LAS unsigned char* qb = lds + (c & 1) * 65536; LAS unsigned char* kb = qb + 16384; LAS unsigned char* ktb = qb + 32768; LAS unsigned char* vtb = qb + 49152;
        if (w < 4) {
            const int jb = w & 1, ib = w >> 1; f32x16 s;
#pragma unroll
            for (int i = 0; i < 16; ++i) s[i] = 0.f;
#pragma unroll
            for (int ks = 0; ks < 8; ++ks) { const unsigned cc = (unsigned)(2 * ks) << 4;
                const bf16x8 a = *(const LAS bf16x8*)(kb + (32 * jb + pr) * 256 + (x16p ^ cc)); const bf16x8 b = *(const LAS bf16x8*)(qb + (32 * ib + r) * 256 + (x16 ^ cc)); s = MFMA32(a, b, s); }
            const int iq = 32 * ib + r;
#pragma unroll
            for (int i = 0; i < 16; ++i) { const int j = 32 * jb + pi32(crow(i, h)); const int dd = iq > j ? iq - j : j - iq; s[i] *= exp2f(lg2 * (float)dd); }
#pragma unroll
            for (int s2 = 0; s2 < 2; ++s2) { const unsigned cc = (unsigned)(4 * jb + 2 * s2) << 4; *(LAS bf16x8*)(pimg + iq * 128 + ((((unsigned)((iq >> 1) & 7) ^ h) << 4) ^ cc)) = pack_regs(s, s2); }
        }
        asm volatile("s_waitcnt lgkmcnt(0)" ::: "memory"); __builtin_amdgcn_s_barrier(); asm volatile("" ::: "memory");
        f32x16 o[2];
        if (w < 4) {
            bf16x8 vf[4];
#pragma unroll
            for (int ks = 0; ks < 4; ++ks) vf[ks] = *(const LAS bf16x8*)(vtb + (32 * w + r) * 128 + (x8 ^ ((unsigned)(2 * ks) << 4)));
            const float qd0 = exp2f(lg2 * (float)(r + 1)), qd1 = exp2f(lg2 * (float)(33 + r));
#pragma unroll
            for (int ib = 0; ib < 2; ++ib)
#pragma unroll
                for (int i = 0; i < 16; ++i) o[ib][i] = 0.f;
#pragma unroll
            for (int d = 0; d < 4; ++d)
#pragma unroll
                for (int s2 = 0; s2 < 2; ++s2) { const bf16x8 a = pack_regs(S[d], s2);
                    const unsigned c0 = (unsigned)(4 * d + 2 * s2), c1 = c0 + 1;
#pragma unroll
                    for (int ib = 0; ib < 2; ++ib) { const int iq = 32 * ib + r; const unsigned sw = (unsigned)(iq & 15);
                        const s16x4 lo = *(const LAS s16x4*)(qb + iq * 256 + ((c0 ^ sw) << 4) + 8 * h); const s16x4 hi = *(const LAS s16x4*)(qb + iq * 256 + ((c1 ^ sw) << 4) + 8 * h);
                        const bf16x8 b = __builtin_shufflevector(lo, hi, 0, 1, 2, 3, 4, 5, 6, 7); o[ib] = MFMA32(a, b, o[ib]); } }
#pragma unroll
            for (int i = 0; i < 16; ++i) { o[0][i] *= qd0; o[1][i] *= qd1; }
#pragma unroll
            for (int ib = 0; ib < 2; ++ib) { const int iq = 32 * ib + r;
#pragma unroll
                for (int ks = 0; ks < 4; ++ks) { const bf16x8 b = *(const LAS bf16x8*)(pimg + iq * 128 + (x8 ^ ((unsigned)(2 * ks) << 4))); o[ib] = MFMA32(vf[ks], b, o[ib]); } }
#pragma unroll
            for (int d = 0; d < 4; ++d) {
#pragma unroll
                for (int i = 0; i < 16; ++i) S[d][i] *= cdec;
#pragma unroll
                for (int ks = 0; ks < 4; ++ks) { const bf16x8 a = *(const LAS bf16x8*)(ktb + (32 * d + r) * 128 + (x8 ^ ((unsigned)(2 * ks) << 4))); S[d] = MFMA32(a, vf[ks], S[d]); } }
#pragma unroll
            for (int ib = 0; ib < 2; ++ib) { float ss = 0.f;
#pragma unroll
                for (int i = 0; i < 16; ++i) ss += o[ib][i] * o[ib][i];
                ss += shx(ss, 32); if (h == 0) red[w * 64 + 32 * ib + r] = ss; }
        }
        asm volatile("s_waitcnt lgkmcnt(0)" ::: "memory"); __builtin_amdgcn_s_barrier(); asm volatile("" ::: "memory");
        if (w < 4) {
#pragma unroll
            for (int ib = 0; ib < 2; ++ib) { const int iq = 32 * ib + r; const float tot = red[iq] + red[64 + iq] + red[128 + iq] + red[192 + iq]; const float rs = rsqrtf(tot * (1.0f / 128.0f) + EPSN);
                bf16_t* grow = gate + (size_t)(c * 64 + iq) * 512 + 32 * w;
#pragma unroll
                for (int gq = 0; gq < 4; ++gq) { const int dv = 8 * gq + 4 * h; const u32x2 gw = *(const u32x2*)(grow + dv); u32x2 ow;
                    ow.x = pk2(o[ib][4 * gq] * rs * siluf_(lo2f(gw.x)), o[ib][4 * gq + 1] * rs * siluf_(hi2f(gw.x))); ow.y = pk2(o[ib][4 * gq + 2] * rs * siluf_(lo2f(gw.y)), o[ib][4 * gq + 3] * rs * siluf_(hi2f(gw.y)));
                    *(u32x2*)(grow + dv) = ow; } }
        }
    }
#undef RET_STAGE
    __builtin_amdgcn_s_barrier();
}

DI float gelu_tanh(float y) { const float a = 0.7978845608028654f * (y + 0.044715f * y * y * y); const float e = __expf(2.0f * a); return 0.5f * y * (2.0f - 2.0f * __builtin_amdgcn_rcpf(e + 1.0f)); }
DI void s5_item(LAS unsigned char* lds, const Params& p, int layer, int bslab, int g) {
    const int tid_ = opaque_tid(); const int lane = tid_ & 63, w = __builtin_amdgcn_readfirstlane(tid_ >> 6), r = lane & 31, h = lane >> 5, fr = lane & 15, fq = lane >> 4;
    LAS unsigned char* img = lds + w * 8704;
    const int lg = layer * 32 + g;
    bf16x8 bfr[4], cfr[4];
#pragma unroll
    for (int sb = 0; sb < 4; ++sb) bfr[sb] = *(const bf16x8*)(p.bbar_() + ((size_t)lg * 128 + 32 * sb + r) * 16 + 8 * h);
#pragma unroll
    for (int ks = 0; ks < 4; ++ks) cfr[ks] = *(const bf16x8*)(p.cct_() + ((size_t)lg * 16 + fr) * 128 + 32 * ks + 8 * fq);
    const float are = p.abar_()[((size_t)lg * 64 + lane) * 2], aim = p.abar_()[((size_t)lg * 64 + lane) * 2 + 1];
    const f32x4 dsk = *(const f32x4*)(p.ssm_d + layer * 512 + g * 16 + 4 * fq);
    float xr = 0.f, xi = 0.f;
    const bf16_t* ub = p.pc(0) + (size_t)bslab * SEQ * 512 + g * 16; bf16_t* zb = p.zbuf_() + (size_t)bslab * SEQ * 512 + g * 16;
    bf16x8 uf = *(const bf16x8*)(ub + (size_t)r * 512 + 8 * h);
    for (int t0 = 0; t0 < SEQ; t0 += 32) {
        const bf16x8 ucur = uf;
        if (t0 + 32 < SEQ) uf = *(const bf16x8*)(ub + (size_t)(t0 + 32 + r) * 512 + 8 * h);
#pragma unroll
        for (int sb = 0; sb < 4; ++sb) { f32x16 z;
#pragma unroll
            for (int i = 0; i < 16; ++i) z[i] = 0.f;
            z = MFMA32(bfr[sb], ucur, z);
#pragma unroll
            for (int gq = 0; gq < 4; ++gq) { u32x2 wv; wv.x = pk2(z[4 * gq], z[4 * gq + 1]); wv.y = pk2(z[4 * gq + 2], z[4 * gq + 3]); *(LAS u32x2*)(img + r * 272 + (32 * sb + 8 * gq + 4 * h) * 2) = wv; } }
        asm volatile("s_waitcnt lgkmcnt(0)" ::: "memory");
#pragma unroll 8
        for (int t = 0; t < 32; ++t) { LAS bf16_t* row = (LAS bf16_t*)(img + t * 272);
            const float br = bf2f(row[lane]), bi = bf2f(row[64 + lane]);
            const float nr = fmaf(are, xr, fmaf(-aim, xi, br)), ni = fmaf(are, xi, fmaf(aim, xr, bi)); xr = nr; xi = ni;
            row[lane] = f2bf(xr); row[64 + lane] = f2bf(xi); }
        asm volatile("s_waitcnt lgkmcnt(0)" ::: "memory");
#pragma unroll
        for (int tb = 0; tb < 2; ++tb) { f32x4 y = {0.f, 0.f, 0.f, 0.f};
#pragma unroll
            for (int ks = 0; ks < 4; ++ks) { const bf16x8 b = *(const LAS bf16x8*)(img + (16 * tb + fr) * 272 + (32 * ks + 8 * fq) * 2); y = MFMA16(cfr[ks], b, y); }
            const u32x4 uw = __builtin_bit_cast(u32x4, ucur); const int src = 16 * tb + fr + 32 * (fq >> 1);
            const unsigned d0 = shl_u(uw.x, src), d1 = shl_u(uw.y, src), d2 = shl_u(uw.z, src), d3 = shl_u(uw.w, src);
            const unsigned ua = (fq & 1) ? d2 : d0, ubw = (fq & 1) ? d3 : d1;
            const float y0 = y[0] + dsk[0] * lo2f(ua), y1 = y[1] + dsk[1] * hi2f(ua), y2 = y[2] + dsk[2] * lo2f(ubw), y3 = y[3] + dsk[3] * hi2f(ubw);
            u32x2 ow; ow.x = pk2(gelu_tanh(y0), gelu_tanh(y1)); ow.y = pk2(gelu_tanh(y2), gelu_tanh(y3));
            *(u32x2*)(zb + (size_t)(t0 + 16 * tb + fr) * 512 + 4 * fq) = ow; }
    }
}
DI float rfl(float v) { int i = __builtin_amdgcn_readfirstlane(__float_as_int(v)); asm volatile("" : "+s"(i)); return __int_as_float(i); }
DI void phase_mixers(const Params& p, LAS unsigned char* lds, int layer, int slab) {
    const int tid = opaque_tid(), w = __builtin_amdgcn_readfirstlane(tid >> 6);
    const int osb = layer == 0 ? 0x3f4ccccd : 0x3f24fd5c;
    int osb2 = osb; asm volatile("" : "+s"(osb2)); const float oscale_d = __int_as_float(osb2);
    const float* sc = p.scal() + layer * 8; const float lam = rfl(sc[0]), nshift_d = rfl(sc[1]), nshift_m = rfl(sc[2]);
    LAS unsigned* qslot = (LAS unsigned*)(lds + 147440);
    unsigned* ctr = p.ctr_() + (layer * NSLAB + slab) * 256;
    constexpr int N_S5 = SLABB * 32 / 8, N_RET = SLABB * 4, N_DIFF = SLABB * 4 * 32, N_MEM = SLABB * 4 * 32;
#define QUEUE_LOOP(CTR, N, ...) for (;;) { if (tid == 0) *qslot = atomicAdd((CTR), 1u); __syncthreads(); const int item = __builtin_amdgcn_readfirstlane((int)*qslot); __syncthreads(); if (item >= (N)) break; __VA_ARGS__ }
    QUEUE_LOOP(ctr, N_S5, { const int idx = item * 8 + w; s5_item(lds, p, layer, idx >> 5, idx & 31); __syncthreads(); })
    QUEUE_LOOP(ctr + 64, N_RET, { const int b = item >> 2, hd = item & 3;
        ret_item(lds, p.pc(2) + (size_t)b * SEQ * 512 + hd * 128, p.pc(3) + (size_t)b * SEQ * 512 + hd * 128, p.pt(0) + (size_t)(hd * 128) * TS + (size_t)b * SEQ,
                 p.pt(1) + (size_t)(hd * 128) * TS + (size_t)b * SEQ, p.pc(5) + (size_t)b * SEQ * 512 + hd * 128, hd); })
    QUEUE_LOOP(ctr + 128, N_DIFF, { const int qt = 31 - (item >> 4), b = (item >> 2) & 3, hd = item & 3;
        const size_t qo = ((size_t)b * SEQ + 256 * qt) * 512 + hd * 128;
        attn_item<2>(lds, p.pc(6) + qo, nullptr, p.pc(7) + (size_t)b * SEQ * 512 + hd * 128, 512, p.pt(2) + (size_t)(hd * 128) * TS + (size_t)b * SEQ, TS,
                     4 * qt + 4, 4 * qt + 1, nshift_d, p.pc(9) + qo, p.hn_g + layer * 128, lam, oscale_d); })
    QUEUE_LOOP(ctr + 192, N_MEM, { const int qt = item >> 4, b = (item >> 2) & 3, hd = item & 3; const int bg = slab * SLABB + b;
        const size_t qo = ((size_t)b * SEQ + 256 * qt) * 512 + hd * 128;
        attn_item<1>(lds, p.pc(10) + qo, p.mq_g + layer * 128, p.mk_() + ((size_t)layer * 2048 + bg * 256) * 512 + hd * 128, 512,
                     p.mvt_() + ((size_t)layer * 512 + hd * 128) * 2048 + bg * 256, 2048, 4, 4, nshift_m, p.pc(11) + qo, nullptr, 0.f, 1.0f); })
#undef QUEUE_LOOP
}


#ifndef DBG_STOP
#define DBG_STOP 0
#endif
DI void dbg_sum(const bf16_t* buf, size_t n, float& acc) {
    const size_t gtid = (size_t)blockIdx.x * 512 + threadIdx.x, gn = (size_t)gridDim.x * 512;
    for (size_t i = gtid; i < n / 4; i += gn) { const u32x2 w = *(const u32x2*)(buf + i * 4); acc += lo2f(w.x) + hi2f(w.x) + lo2f(w.y) + hi2f(w.y); }
}
DI void dbg_finish(const Params& p, float acc) {
    const size_t gtid = (size_t)blockIdx.x * 512 + threadIdx.x, gn = (size_t)gridDim.x * 512;
    for (size_t i = gtid; i < (size_t)NBATCH * SEQ * DM; i += gn) p.out[i] = (i == gtid) ? acc : 0.f;
}
__global__ void __launch_bounds__(512, 2) fwd_megakernel(Params p) {
    cg::grid_group grid = cg::this_grid();
#define GSYNC() do { __threadfence(); grid.sync(); } while (0)
    extern __shared__ __attribute__((aligned(16))) unsigned char shm[];
    LAS unsigned char* lds = (LAS unsigned char*)shm;
    const int G = gridDim.x, c = blockIdx.x;
    phase_prep(p, lds);
    GSYNC();
    { SchedKV S{p, G, c}; EpiKV E{p}; pg8::gemm_phase(lds, 1024, S, E); }
    GSYNC();
#pragma unroll 1
    for (int layer = 0; layer < DEPTH; ++layer)
#pragma unroll 1
        for (int slab = 0; slab < NSLAB; ++slab) {
            const float* xin = (layer == 0 ? p.x : p.out) + (size_t)slab * TS * DM; float* xout = p.out + (size_t)slab * TS * DM;
            phase_norm(p, xin);
            if (layer == 0 && slab == 0) phase_mknorm(p);
            GSYNC();
            { SchedIn S{p, layer, G, c}; EpiIn E{p, layer}; pg8::gemm_phase(lds, 1024, S, E); }
            GSYNC();
            if (DBG_STOP == 1) { float a_ = 0.f; dbg_sum(p.pcb_(), (size_t)13 * TS * 512, a_); dbg_sum(p.gates_(), (size_t)4 * TS * 1024, a_); dbg_finish(p, a_); return; }
            phase_rope(p, layer);
            GSYNC();
            if (DBG_STOP == 2) { float a_ = 0.f; dbg_sum(p.pcb_(), (size_t)13 * TS * 512, a_); dbg_finish(p, a_); return; }
            phase_mixers(p, lds, layer, slab);
            GSYNC();
            if (DBG_STOP == 3) { float a_ = 0.f; dbg_sum(p.pcb_(), (size_t)13 * TS * 512, a_); dbg_sum(p.zbuf_(), (size_t)TS * 512, a_); dbg_finish(p, a_); return; }
            { SchedGlu S{p, layer, G, c}; EpiGlu E{p, layer}; pg8::gemm_phase(lds, 512, S, E); }
            GSYNC();
            if (DBG_STOP == 4) { float a_ = 0.f; dbg_sum(p.pc(1), (size_t)TS * 512, a_); dbg_finish(p, a_); return; }
            { SchedMerge S{p, layer, G, c}; EpiMerge E{p.gates_(), p.h_()}; pg8::gemm_phase(lds, 512, S, E); }
            GSYNC();
            if (DBG_STOP == 5) { float a_ = 0.f; dbg_sum(p.h_(), (size_t)TS * 1024, a_); dbg_finish(p, a_); return; }
            { SchedOut S{p, layer, G, c}; EpiOut E{xin, xout}; pg8::gemm_phase(lds, 1024, S, E); }
            GSYNC();
        }
}

extern "C" void kernel_launch(void* const* d_in, const int* in_sizes, int n_in, void* d_out, int out_size, void* d_ws, size_t ws_size, hipStream_t stream) {
    constexpr size_t kDynLds = 147456;
    static int grid_blocks = 0;
    if (!grid_blocks) {
        int dev = 0, cus = 0, per_cu = 0;
        (void)hipGetDevice(&dev);
        (void)hipDeviceGetAttribute(&cus, hipDeviceAttributeMultiprocessorCount, dev);
        (void)hipFuncSetAttribute((const void*)fwd_megakernel, hipFuncAttributeMaxDynamicSharedMemorySize, (int)kDynLds);
        (void)hipOccupancyMaxActiveBlocksPerMultiprocessor(&per_cu, fwd_megakernel, 512, kDynLds);
        if (per_cu < 1) per_cu = 1;
        grid_blocks = cus * per_cu;
    }
    Params p{};
    const float** f = (const float**)&p;
    for (int i = 0; i < 28; ++i) f[i] = (const float*)d_in[i];
    p.out = (float*)d_out;
    p.wsb = (char*)d_ws; const size_t off = O_END;
    if (off > ws_size) { fprintf(stderr, "workspace too small: need %zu have %zu\n", off, ws_size); return; }
    (void)hipMemsetAsync(p.wsb + O_CTR, 0, 4096, stream);
    void* args[] = {&p};
    hipError_t e = hipLaunchCooperativeKernel((void*)fwd_megakernel, dim3(grid_blocks), dim3(512), args, kDynLds, stream);
    if (e != hipSuccess) fprintf(stderr, "cooperative launch failed: %s (grid %d)\n", hipGetErrorString(e), grid_blocks);
}
```

```cpp
#include <hip/hip_runtime.h>
#include <hip/hip_cooperative_groups.h>
#include <cstdio>
namespace cg = cooperative_groups;
#define LAS __attribute__((address_space(3)))
#define DI __device__ __forceinline__
typedef unsigned short bf16_t;
typedef short bf16x8 __attribute__((ext_vector_type(8)));
typedef short s16x4 __attribute__((ext_vector_type(4)));
typedef float f32x4 __attribute__((ext_vector_type(4)));
typedef float f32x16 __attribute__((ext_vector_type(16)));
typedef unsigned u32x4 __attribute__((ext_vector_type(4)));
typedef unsigned u32x2 __attribute__((ext_vector_type(2)));

constexpr int DM = 1024, NBATCH = 8, SEQ = 8192, DEPTH = 2, BW = 512, INC = 10240, MEML = 256;
constexpr int SLABB = 4, TS = SLABB * SEQ  , NSLAB = NBATCH / SLABB;
constexpr float EPSN = 1e-6f;

DI float bf2f(bf16_t b) { return __uint_as_float(((unsigned)b) << 16); }
DI bf16_t f2bf(float f) { unsigned u = __float_as_uint(f); u += 0x7FFFu + ((u >> 16) & 1u); return (bf16_t)(u >> 16); }
typedef __bf16 bf16n2 __attribute__((ext_vector_type(2)));
typedef float f32x2 __attribute__((ext_vector_type(2)));
DI unsigned pk2(float lo, float hi) { const f32x2 v = {lo, hi}; return __builtin_bit_cast(unsigned, __builtin_convertvector(v, bf16n2)); }
DI float lo2f(unsigned w) { return __uint_as_float(w << 16); }
DI float hi2f(unsigned w) { return __uint_as_float(w & 0xffff0000u); }
DI float sigmoidf_(float v) { return __builtin_amdgcn_rcpf(1.0f + __expf(-v)); }
DI float siluf_(float v) { return v * sigmoidf_(v); }
constexpr int WID_TABLE_OFF = 147456 - 16 - 256;
DI int hw_slot() { unsigned v; asm volatile("s_getreg_b32 %0, hwreg(HW_REG_HW_ID)" : "=s"(v)); return (int)((v & 15u) | (((v >> 4) & 3u) << 4)); }
DI int opaque_tid() { const int slot = hw_slot(); const int wid = __builtin_amdgcn_readfirstlane(*(const LAS int*)(size_t)(WID_TABLE_OFF + slot * 4));
    int lane; asm volatile("v_mbcnt_lo_u32_b32 %0, -1, 0\n\tv_mbcnt_hi_u32_b32 %0, -1, %0" : "=v"(lane)); return (wid << 6) | lane; }
DI void init_wid_table() { const int slot = hw_slot(); if ((threadIdx.x & 63) == 0) *(LAS int*)(size_t)(WID_TABLE_OFF + slot * 4) = (int)(threadIdx.x >> 6); __syncthreads(); }
DI int opaque_lane() { int lane; asm volatile("v_mbcnt_lo_u32_b32 %0, -1, 0\n\tv_mbcnt_hi_u32_b32 %0, -1, %0" : "=v"(lane)); return lane; }
DI float shx(float v, int m) { return __int_as_float(__builtin_amdgcn_ds_bpermute((opaque_lane() ^ m) << 2, __float_as_int(v))); }
DI unsigned shl_u(unsigned v, int src) { return (unsigned)__builtin_amdgcn_ds_bpermute(src << 2, (int)v); }
DI float wave_sum(float v) { for (int o = 32; o > 0; o >>= 1) v += shx(v, o); return v; }
DI float wave_max(float v) { for (int o = 32; o > 0; o >>= 1) v = fmaxf(v, shx(v, o)); return v; }

namespace pg8 {
constexpr int BM = 256, BK = 64, HALF = 128, HTB = HALF * BK * 2, STAGE_BYTES = 8 * HTB, NXCD = 8, WGM = 8;
__host__ __device__ __forceinline__ int lds_byte(int r, int c) { const int st = (r >> 4) * 2 + (c >> 5), rr = r & 15, cc = c & 31, ob = rr * 64 + cc * 2; return st * 1024 + (ob ^ (((ob >> 9) & 1) << 5)); }
__host__ __device__ __forceinline__ void stage_rc(int b, int& R, int& C) { const int st = b / 1024, sb = b % 1024, swz = sb ^ (((sb >> 9) & 1) << 5); R = (st >> 1) * 16 + swz / 64; C = (st & 1) * 32 + (swz % 64) / 2; }
__host__ __device__ __forceinline__ int perm32(int rho) { const int n = rho >> 4, i = rho & 15; return 8 * (i >> 2) + 4 * n + (i & 3); }

struct Unit { const char* A; const char* B; int row0, col0, aux; };

DI void tile_of(int L, int nM, int nN, int& pm, int& pn) {
    const int nwg = nM * nN; int wgid = L; { const int q = nwg / NXCD, r = nwg % NXCD, xcd = wgid % NXCD, off = wgid / NXCD; wgid = (xcd < r ? xcd * (q + 1) : r * (q + 1) + (xcd - r) * q) + off; }
    const int nig = WGM * nN, gid = wgid / nig, fm = gid * WGM, gsz = (nM - fm) < WGM ? (nM - fm) : WGM;
    pm = fm + ((wgid % nig) % gsz); pn = (wgid % nig) / gsz;
}

template <class Epi, class Sched>
DI void gemm_phase(LAS unsigned char* lds, const int K, const Sched& S, const Epi& E) {
    const int tid = opaque_tid(), wid = __builtin_amdgcn_readfirstlane(tid >> 6), lane = tid & 63, wr = wid >> 2, wc = wid & 3, fr = lane & 15, fq = lane >> 4;
    const int nt = K / BK;
    unsigned voffA[2], voffB[2];
#pragma unroll
    for (int i = 0; i < 2; ++i) { int R, C; stage_rc(tid * 16 + i * 8192, R, C); const int Rb = Epi::PERM ? ((R & ~31) + perm32(R & 31)) : R;
        voffA[i] = (unsigned)(R * K + C) * 2u; voffB[i] = (unsigned)(Rb * K + C) * 2u; }
    const size_t kstep = (size_t)(BK * 2);
    const size_t hstep = (size_t)HALF * K * 2;
    const unsigned ldsw = (unsigned)wid * 1024u;
    const int aoff = lds_byte(wr * 64 + fr, fq * 8), boff = lds_byte(wc * 32 + fr, fq * 8);
#define PG8_SA(b, h) (((b) * 2 + (h)) * HTB)
#define PG8_SB(b, h) ((4 + (b) * 2 + (h)) * HTB)
#define PG8_STAGE(bufoff, gbase, voff) do { _Pragma("unroll") for (int _i = 0; _i < 2; ++_i) \
        __builtin_amdgcn_global_load_lds((const unsigned*)((const char*)(gbase) + (voff)[_i]), (LAS unsigned*)(lds + (bufoff) + ldsw + _i * 8192), 16, 0, 0); } while (0)
#define PG8_LDA(dst, b, h) do { _Pragma("unroll") for (int m = 0; m < 4; ++m) _Pragma("unroll") for (int k = 0; k < 2; ++k) dst[m][k] = *(const LAS bf16x8*)(lds + PG8_SA(b, h) + aoff + m * 2048 + k * 1024); } while (0)
#define PG8_LDB(dst, b, h) do { _Pragma("unroll") for (int n = 0; n < 2; ++n) _Pragma("unroll") for (int k = 0; k < 2; ++k) dst[n][k] = *(const LAS bf16x8*)(lds + PG8_SB(b, h) + boff + n * 2048 + k * 1024); } while (0)
#define PG8_MMA(ai, bj, At, Bt) do { __builtin_amdgcn_s_setprio(1); _Pragma("unroll") for (int m = 0; m < 4; ++m) _Pragma("unroll") for (int n = 0; n < 2; ++n) _Pragma("unroll") for (int k = 0; k < 2; ++k) \
        acc[ai][bj][m][n] = __builtin_amdgcn_mfma_f32_16x16x32_bf16(Bt[n][k], At[m][k], acc[ai][bj][m][n], 0, 0, 0); __builtin_amdgcn_s_setprio(0); } while (0)
#define PG8_WAIT_V(n) asm volatile("s_waitcnt vmcnt(" #n ")" ::: "memory")
#define PG8_WAIT_L(n) asm volatile("s_waitcnt lgkmcnt(" #n ")" ::: "memory")
#define PG8_BAR __builtin_amdgcn_s_barrier()
#define PG8_SCHED __builtin_amdgcn_sched_barrier(0)
    Unit cur, nxt; int ui = 0;
    if (!S.next(0, cur)) return;
    f32x4 acc[2][2][4][2];
#pragma unroll
    for (int a = 0; a < 2; ++a)
#pragma unroll
        for (int b = 0; b < 2; ++b)
#pragma unroll
            for (int m = 0; m < 4; ++m)
#pragma unroll
                for (int n = 0; n < 2; ++n) acc[a][b][m][n] = (f32x4){0.f, 0.f, 0.f, 0.f};
    bf16x8 At[4][2], B0[2][2], B1[2][2];
    const char* cA = cur.A; const char* cB = cur.B;
    PG8_STAGE(PG8_SB(0, 0), cB, voffB); PG8_STAGE(PG8_SA(0, 0), cA, voffA); PG8_STAGE(PG8_SB(0, 1), cB + hstep, voffB); PG8_STAGE(PG8_SA(0, 1), cA + hstep, voffA);
    if (wr == 1) PG8_BAR;
    PG8_WAIT_V(4); PG8_BAR;
    PG8_STAGE(PG8_SB(1, 0), cB + kstep, voffB); PG8_STAGE(PG8_SA(1, 0), cA + kstep, voffA); PG8_STAGE(PG8_SB(1, 1), cB + hstep + kstep, voffB);
    PG8_WAIT_V(6); PG8_BAR;
    for (;;) {
        const bool has_next = S.next(ui + 1, nxt);
        const char* nA = has_next ? nxt.A : cA; const char* nB = has_next ? nxt.B : cB;
        for (int t = 0; t < nt; t += 2) {
            const bool last = (t == nt - 2);
            const char* a1 = cA + (size_t)(t + 1) * kstep;
            const char* a2 = last ? nA : cA + (size_t)(t + 2) * kstep; const char* b2 = last ? nB : cB + (size_t)(t + 2) * kstep;
            const char* a3 = a2 + kstep; const char* b3 = b2 + kstep;
            PG8_LDB(B0, 0, 0); PG8_SCHED; PG8_LDA(At, 0, 0); PG8_STAGE(PG8_SA(1, 1), a1 + hstep, voffA);
            PG8_WAIT_L(8); PG8_BAR; PG8_WAIT_L(0); PG8_MMA(0, 0, At, B0); PG8_BAR; PG8_SCHED;
            PG8_LDB(B1, 0, 1); PG8_STAGE(PG8_SB(0, 0), b2, voffB);
            PG8_BAR; PG8_WAIT_L(0); PG8_MMA(0, 1, At, B1); PG8_BAR;
            PG8_LDA(At, 0, 1); PG8_STAGE(PG8_SA(0, 0), a2, voffA);
            PG8_BAR; PG8_WAIT_L(0); PG8_MMA(1, 0, At, B0); PG8_BAR; PG8_SCHED;
            PG8_STAGE(PG8_SB(0, 1), b2 + hstep, voffB);
            PG8_WAIT_V(6); PG8_BAR; PG8_MMA(1, 1, At, B1); PG8_BAR;
            PG8_LDB(B0, 1, 0); PG8_SCHED; PG8_LDA(At, 1, 0); PG8_STAGE(PG8_SA(0, 1), a2 + hstep, voffA);
            PG8_WAIT_L(8); PG8_BAR; PG8_WAIT_L(0); PG8_MMA(0, 0, At, B0); PG8_BAR; PG8_SCHED;
            PG8_LDB(B1, 1, 1); PG8_STAGE(PG8_SB(1, 0), b3, voffB);
            PG8_BAR; PG8_WAIT_L(0); PG8_MMA(0, 1, At, B1); PG8_BAR;
            PG8_LDA(At, 1, 1); PG8_STAGE(PG8_SA(1, 0), a3, voffA);
            PG8_BAR; PG8_WAIT_L(0); PG8_MMA(1, 0, At, B0); PG8_BAR; PG8_SCHED;
            PG8_STAGE(PG8_SB(1, 1), b3 + hstep, voffB);
            PG8_WAIT_V(6); PG8_BAR; PG8_MMA(1, 1, At, B1); PG8_BAR;
        }
        const bool zero = E(acc, cur, wr, wc, fr, fq);
        if (!has_next) break;
        if (zero) {
#pragma unroll
        for (int a = 0; a < 2; ++a)
#pragma unroll
            for (int b = 0; b < 2; ++b)
#pragma unroll
                for (int m = 0; m < 4; ++m)
#pragma unroll
                    for (int n = 0; n < 2; ++n) acc[a][b][m][n] = (f32x4){0.f, 0.f, 0.f, 0.f};
        }
        cur = nxt; cA = nA; cB = nB; ++ui;
    }
    PG8_WAIT_V(0);
    if (wr == 0) PG8_BAR;
    PG8_BAR;
#undef PG8_SA
#undef PG8_SB
#undef PG8_STAGE
#undef PG8_LDA
#undef PG8_LDB
#undef PG8_MMA
#undef PG8_WAIT_V
#undef PG8_WAIT_L
#undef PG8_BAR
#undef PG8_SCHED
}
}
using pg8::Unit;
constexpr size_t al256(size_t v) { return (v + 255) & ~(size_t)255; }
constexpr size_t O_CTR = 0, O_WTIN = 8192, O_WTGLU = O_WTIN + al256((size_t)DEPTH * INC * DM * 2), O_WTBR = O_WTGLU + al256((size_t)DEPTH * 512 * 512 * 2), O_WTOUT = O_WTBR + al256((size_t)DEPTH * 4 * 1024 * 512 * 2),
    O_WTKV = O_WTOUT + al256((size_t)DEPTH * DM * DM * 2), O_MEMH = O_WTKV + al256((size_t)DEPTH * DM * DM * 2), O_MK = O_MEMH + al256((size_t)2048 * DM * 2), O_MVT = O_MK + al256((size_t)DEPTH * 2048 * 512 * 2),
    O_DCOS = O_MVT + al256((size_t)DEPTH * 512 * 2048 * 2), O_DSIN = O_DCOS + al256((size_t)SEQ * 32 * 4), O_RCOS = O_DSIN + al256((size_t)SEQ * 32 * 4), O_RSIN = O_RCOS + al256((size_t)SEQ * 64 * 4),
    O_RCOST = O_RSIN + al256((size_t)SEQ * 64 * 4), O_RSINT = O_RCOST + al256((size_t)SEQ * 64 * 4), O_ABAR = O_RSINT + al256((size_t)SEQ * 64 * 4), O_BBAR = O_ABAR + al256((size_t)DEPTH * 32 * 64 * 2 * 4),
    O_CCT = O_BBAR + al256((size_t)DEPTH * 32 * 128 * 16 * 2), O_H = O_CCT + al256((size_t)DEPTH * 32 * 16 * 128 * 2), O_ZBUF = O_H + al256((size_t)TS * DM * 2), O_GATES = O_ZBUF + al256((size_t)TS * 512 * 2),
    O_PCB = O_GATES + al256((size_t)4 * TS * 1024 * 2), O_END = O_PCB + al256((size_t)16 * TS * 512 * 2);
struct WsView {
    char* b;
    DI unsigned* ctr() const { return (unsigned*)(b + O_CTR); }
    DI bf16_t* at(size_t o) const { return (bf16_t*)(b + o); }
    DI float* fat(size_t o) const { return (float*)(b + o); }
};
struct Params {
    const float *x, *mem, *norm_g, *w_in, *lam_re, *lam_im, *log_dt, *b_re, *b_im, *c_re, *c_im, *ssm_d, *w_glu, *b_glu;
    const float *dq_g, *dk_g, *lq1, *lk1, *lq2, *lk2, *hn_g, *mem_norm_g, *w_mem_kv, *mq_g, *mk_g, *w_branch, *b_merge, *w_out;
    float* out;
    char* wsb;
    DI const float* scal() const { char* b_ = wsb; asm volatile("" : "+s"(b_)); return (const float*)(__attribute__((address_space(1))) char*)(b_ + O_CTR + 4096); }
#define WSF(name, T, OFF) DI T* name##_() const { char* b_ = wsb; asm volatile("" : "+s"(b_)); return (T*)(__attribute__((address_space(1))) char*)(b_ + (OFF)); }
    WSF(ctr, unsigned, O_CTR) WSF(wt_in, bf16_t, O_WTIN) WSF(wt_glu, bf16_t, O_WTGLU) WSF(wt_br, bf16_t, O_WTBR) WSF(wt_out, bf16_t, O_WTOUT) WSF(wt_kv, bf16_t, O_WTKV) WSF(memh, bf16_t, O_MEMH)
    WSF(mk, bf16_t, O_MK) WSF(mvt, bf16_t, O_MVT) WSF(dcos, float, O_DCOS) WSF(dsin, float, O_DSIN) WSF(rcos, float, O_RCOS) WSF(rsin, float, O_RSIN) WSF(rcosT, float, O_RCOST) WSF(rsinT, float, O_RSINT)
    WSF(abar, float, O_ABAR) WSF(bbar, bf16_t, O_BBAR) WSF(cct, bf16_t, O_CCT) WSF(h, bf16_t, O_H) WSF(zbuf, bf16_t, O_ZBUF) WSF(gates, bf16_t, O_GATES) WSF(pcb, bf16_t, O_PCB)
#undef WSF
    DI bf16_t* hs(int slab) const { char* b_ = wsb; asm volatile("" : "+s"(b_)); return (bf16_t*)(__attribute__((address_space(1))) char*)(b_ + (slab ? O_END : O_H)); }
    DI bf16_t* pc(int i) const { return pcb_() + (size_t)i * TS * 512; }
    DI bf16_t* pt(int i) const { return pcb_() + (size_t)(i == 0 ? 12 : (i == 1 ? 4 : 8)) * TS * 512; }
};

#define FOR_ACC_PERM(...) \
    _Pragma("unroll") for (int ai = 0; ai < 2; ++ai) _Pragma("unroll") for (int m = 0; m < 4; ++m) { const int row = u.row0 + ai * 128 + wr * 64 + m * 16 + fr; \
    _Pragma("unroll") for (int bj = 0; bj < 2; ++bj) { const int col = u.col0 + bj * 128 + wc * 32 + 8 * fq; f32x4& v0 = acc[ai][bj][m][0]; f32x4& v1 = acc[ai][bj][m][1]; __VA_ARGS__ asm volatile("" ::: "memory"); } }

DI u32x4 pack8(const f32x4& v0, const f32x4& v1) { u32x4 w; w.x = pk2(v0[0], v0[1]); w.y = pk2(v0[2], v0[3]); w.z = pk2(v1[0], v1[1]); w.w = pk2(v1[2], v1[3]); return w; }
DI void unpack8(const u32x4 w, float (&f)[8]) { f[0] = lo2f(w.x); f[1] = hi2f(w.x); f[2] = lo2f(w.y); f[3] = hi2f(w.y); f[4] = lo2f(w.z); f[5] = hi2f(w.z); f[6] = lo2f(w.w); f[7] = hi2f(w.w); }

struct EpiIn {
    static constexpr bool PERM = true;
    Params p; int layer;
    DI bool operator()(f32x4 (&acc)[2][2][4][2], const Unit& u, int wr, int wc, int fr, int fq) const {
        const int v = u.aux;
        if (v >= 36) {
            const int sv = v - 36;
            if (sv < 2) {
                bf16_t* dst = p.pt(0); const int hd = (u.row0 >> 7) + wr; const float lg2 = log2f(1.0f - exp2f(-5.0f - (float)hd));
#pragma unroll
                for (int m = 0; m < 4; ++m) { const int d1 = 16 * m + fr; const float* ct_ = p.rcosT_() + (size_t)d1 * SEQ; const float* st_ = p.rsinT_() + (size_t)d1 * SEQ;
                    const size_t r1 = (size_t)(u.row0 + 128 * wr + d1) * TS;
                    f32x4 tb_[2][4];
#pragma unroll
                    for (int bj = 0; bj < 2; ++bj) { const int pos = (u.col0 + bj * 128 + wc * 32 + 8 * fq) & (SEQ - 1);
                        tb_[bj][0] = *(const f32x4*)(ct_ + pos); tb_[bj][1] = *(const f32x4*)(ct_ + pos + 4); tb_[bj][2] = *(const f32x4*)(st_ + pos); tb_[bj][3] = *(const f32x4*)(st_ + pos + 4); }
#pragma unroll
                    for (int bj = 0; bj < 2; ++bj) { const int col = u.col0 + bj * 128 + wc * 32 + 8 * fq; const int pos = col & (SEQ - 1);
                        const f32x4 c0 = tb_[bj][0], c1 = tb_[bj][1], s0 = tb_[bj][2], s1 = tb_[bj][3];
                        const f32x4 a0 = acc[0][bj][m][0], a1 = acc[0][bj][m][1], b0 = acc[1][bj][m][0], b1 = acc[1][bj][m][1]; f32x4 o0, o1, q0, q1;
#pragma unroll
                        for (int j = 0; j < 4; ++j) { const float k0 = 0.08838834764831845f * exp2f(lg2 * (float)(63 - ((pos + j) & 63))), k1 = 0.08838834764831845f * exp2f(lg2 * (float)(63 - ((pos + 4 + j) & 63)));
                            o0[j] = (a0[j] * c0[j] - b0[j] * s0[j]) * k0; q0[j] = (b0[j] * c0[j] + a0[j] * s0[j]) * k0; o1[j] = (a1[j] * c1[j] - b1[j] * s1[j]) * k1; q1[j] = (b1[j] * c1[j] + a1[j] * s1[j]) * k1; }
                        *(u32x4*)(dst + r1 + col) = pack8(o0, o1); *(u32x4*)(dst + r1 + (size_t)64 * TS + col) = pack8(q0, q1); asm volatile("" ::: "memory"); } }
            } else {
                bf16_t* dst = p.pt(sv >> 1);
                FOR_ACC_PERM({ *(u32x4*)(dst + (size_t)row * TS + col) = pack8(v0, v1); })
            }
        } else {
            const int ct = v < 8 ? v : (v < 14 ? v + 2 : v + 4);
            if (ct >= 4 && ct < 8) {
                bf16_t* dst = p.pc(ct >> 1) + u.col0 + 128 * (wc >> 1) + 32 * (wc & 1) + 8 * fq; const float sc = (ct >= 6) ? 0.08838834764831845f : 1.0f; const int f0 = 32 * (wc & 1) + 8 * fq;
                const float* rc_ = p.rcos_(); const float* rs_ = p.rsin_();
#pragma unroll
                for (int ai = 0; ai < 2; ++ai)
#pragma unroll
                  for (int mh = 0; mh < 2; ++mh) { f32x4 tb_[4][4];
#pragma unroll
                    for (int m = 2 * mh; m < 2 * mh + 2; ++m) { const int pos = (u.row0 + ai * 128 + wr * 64 + m * 16 + fr) & (SEQ - 1); const float* cp = rc_ + (size_t)pos * 64 + f0; const float* sp = rs_ + (size_t)pos * 64 + f0;
                        tb_[m][0] = *(const f32x4*)cp; tb_[m][1] = *(const f32x4*)(cp + 4); tb_[m][2] = *(const f32x4*)sp; tb_[m][3] = *(const f32x4*)(sp + 4); }
#pragma unroll
                    for (int m = 2 * mh; m < 2 * mh + 2; ++m) { const int row = u.row0 + ai * 128 + wr * 64 + m * 16 + fr;
                        const f32x4 c0 = tb_[m][0], c1 = tb_[m][1], s0 = tb_[m][2], s1 = tb_[m][3];
                        const f32x4 a0 = acc[ai][0][m][0], a1 = acc[ai][0][m][1], b0 = acc[ai][1][m][0], b1 = acc[ai][1][m][1]; f32x4 o0, o1, q0, q1;
#pragma unroll
                        for (int j = 0; j < 4; ++j) { o0[j] = (a0[j] * c0[j] - b0[j] * s0[j]) * sc; q0[j] = (b0[j] * c0[j] + a0[j] * s0[j]) * sc; o1[j] = (a1[j] * c1[j] - b1[j] * s1[j]) * sc; q1[j] = (b1[j] * c1[j] + a1[j] * s1[j]) * sc; }
                        *(u32x4*)(dst + (size_t)row * 512) = pack8(o0, o1); *(u32x4*)(dst + (size_t)row * 512 + 64) = pack8(q0, q1); } }
            } else if (ct >= 12 && ct < 16) {
                const bool isq = ct < 14; bf16_t* dst = p.pc(ct >> 1) + u.col0 + 64 * wc + 8 * fq; const float* gn = (isq ? p.dq_g : p.dk_g) + layer * 64 + 8 * fq;
                const f32x4 g0 = *(const f32x4*)gn, g1 = *(const f32x4*)(gn + 4), h0 = *(const f32x4*)(gn + 32), h1 = *(const f32x4*)(gn + 36);
                const float* dc_ = p.dcos_(); const float* ds_ = p.dsin_();
#pragma unroll
                for (int ai = 0; ai < 2; ++ai)
#pragma unroll
                  for (int mh = 0; mh < 2; ++mh) { f32x4 tb_[4][4];
#pragma unroll
                    for (int m = 2 * mh; m < 2 * mh + 2; ++m) { const int pos = (u.row0 + ai * 128 + wr * 64 + m * 16 + fr) & (SEQ - 1); const float* cp = dc_ + (size_t)pos * 32 + 8 * fq; const float* sp = ds_ + (size_t)pos * 32 + 8 * fq;
                        tb_[m][0] = *(const f32x4*)cp; tb_[m][1] = *(const f32x4*)(cp + 4); tb_[m][2] = *(const f32x4*)sp; tb_[m][3] = *(const f32x4*)(sp + 4); }
#pragma unroll
                    for (int m = 2 * mh; m < 2 * mh + 2; ++m) { const int row = u.row0 + ai * 128 + wr * 64 + m * 16 + fr;
                        const f32x4 a0 = acc[ai][0][m][0], a1 = acc[ai][0][m][1], b0 = acc[ai][1][m][0], b1 = acc[ai][1][m][1];
                        float ss = 0.f;
#pragma unroll
                        for (int j = 0; j < 4; ++j) ss += a0[j] * a0[j] + a1[j] * a1[j] + b0[j] * b0[j] + b1[j] * b1[j];
                        ss += shx(ss, 16); ss += shx(ss, 32); const float rs = rsqrtf(ss * (1.0f / 64.0f) + EPSN) * (isq ? 0.125f : 1.0f);
                        const f32x4 c0 = tb_[m][0], c1 = tb_[m][1], s0 = tb_[m][2], s1 = tb_[m][3]; f32x4 o0, o1, q0, q1;
#pragma unroll
                        for (int j = 0; j < 4; ++j) { const float x0 = a0[j] * rs * g0[j], y0 = b0[j] * rs * h0[j], x1 = a1[j] * rs * g1[j], y1 = b1[j] * rs * h1[j];
                            o0[j] = x0 * c0[j] - y0 * s0[j]; q0[j] = y0 * c0[j] + x0 * s0[j]; o1[j] = x1 * c1[j] - y1 * s1[j]; q1[j] = y1 * c1[j] + x1 * s1[j]; }
                        *(u32x4*)(dst + (size_t)row * 512) = pack8(o0, o1); *(u32x4*)(dst + (size_t)row * 512 + 32) = pack8(q0, q1); } }
            } else if (ct < 24) { bf16_t* dst = p.pc(ct >> 1);
                FOR_ACC_PERM({ *(u32x4*)(dst + (size_t)row * 512 + col) = pack8(v0, v1); })
            } else {
                const int d0 = u.col0 + 16 * wc + 4 * fq; const float* bm = p.b_merge + (size_t)layer * 4096 + d0;
                const f32x4 b0 = *(const f32x4*)(bm), b1 = *(const f32x4*)(bm + 1024), b2 = *(const f32x4*)(bm + 2048), b3 = *(const f32x4*)(bm + 3072);
                bf16_t* gp = p.gates_() + d0;
#pragma unroll
                for (int ai = 0; ai < 2; ++ai)
#pragma unroll
                    for (int m = 0; m < 4; ++m) { const size_t ro = (size_t)(u.row0 + ai * 128 + wr * 64 + m * 16 + fr) * 1024; f32x4 g0, g1, g2, g3;
#pragma unroll
                        for (int j = 0; j < 4; ++j) { g0[j] = sigmoidf_(fminf(fmaxf(acc[ai][0][m][0][j] + b0[j], -30.f), 30.f)); g1[j] = sigmoidf_(fminf(fmaxf(acc[ai][0][m][1][j] + b1[j], -30.f), 30.f));
                            g2[j] = sigmoidf_(fminf(fmaxf(acc[ai][1][m][0][j] + b2[j], -30.f), 30.f)); g3[j] = sigmoidf_(fminf(fmaxf(acc[ai][1][m][1][j] + b3[j], -30.f), 30.f)); }
                        u32x2 w0, w1, w2, w3;
                        f32x4 r1, r2, r3;
#pragma unroll
                        for (int j = 0; j < 4; ++j) { r1[j] = __builtin_amdgcn_rcpf(g1[j]); r2[j] = __builtin_amdgcn_rcpf(g2[j]); r3[j] = __builtin_amdgcn_rcpf(g3[j]); }
                        w0.x = pk2(g0[0] * r1[0], g0[1] * r1[1]); w0.y = pk2(g0[2] * r1[2], g0[3] * r1[3]); w1.x = pk2(g1[0] * r2[0], g1[1] * r2[1]); w1.y = pk2(g1[2] * r2[2], g1[3] * r2[3]);
                        w2.x = pk2(g2[0] * r3[0], g2[1] * r3[1]); w2.y = pk2(g2[2] * r3[2], g2[3] * r3[3]); w3.x = pk2(g3[0], g3[1]); w3.y = pk2(g3[2], g3[3]);
                        *(u32x2*)(gp + ro) = w0; *(u32x2*)(gp + (size_t)TS * 1024 + ro) = w1; *(u32x2*)(gp + (size_t)2 * TS * 1024 + ro) = w2; *(u32x2*)(gp + (size_t)3 * TS * 1024 + ro) = w3; }
            }
        }
        return true;
    }
};
struct SchedIn {
    Params p; int layer, G, c; const bf16_t* hb;
    DI bool next(int i, Unit& u) const {
        const int L = i * G + c; if (L >= (TS / 256) * 42) return false;
        int pm, pn; pg8::tile_of(L, TS / 256, 42, pm, pn);
        const char* W = (const char*)(p.wt_in_() + (size_t)layer * INC * DM); const char* H = (const char*)hb;
        u.aux = pn;
        if (pn < 36) { const int ct = pn < 8 ? pn : (pn < 14 ? pn + 2 : pn + 4);
            u.A = H + (size_t)pm * 256 * DM * 2; u.B = W + (size_t)ct * 256 * DM * 2; u.row0 = pm * 256; u.col0 = ct < 24 ? (ct & 1) * 256 : (ct - 24) * 64;
        } else { const int sv = pn - 36; const int piece = sv < 2 ? 3 : (sv < 4 ? 4 : 8);
            u.A = W + (size_t)(piece * 512 + (sv & 1) * 256) * DM * 2; u.B = H + (size_t)pm * 256 * DM * 2; u.row0 = (sv & 1) * 256; u.col0 = pm * 256; }
        return true;
    }
};
struct EpiKV {
    static constexpr bool PERM = true;
    Params p;
    DI bool operator()(f32x4 (&acc)[2][2][4][2], const Unit& u, int wr, int wc, int fr, int fq) const {
        const int layer = u.aux >> 1, sw = u.aux & 1;
        if (sw) { bf16_t* dst = p.mvt_() + (size_t)layer * 512 * 2048; FOR_ACC_PERM({ *(u32x4*)(dst + (size_t)row * 2048 + col) = pack8(v0, v1); }) }
        else { bf16_t* dst = p.mk_() + (size_t)layer * 2048 * 512; FOR_ACC_PERM({ *(u32x4*)(dst + (size_t)row * 512 + col) = pack8(v0, v1); }) }
        return true;
    }
};
struct SchedKV {
    Params p; int G, c;
    DI bool next(int i, Unit& u) const {
        const int L = i * G + c; if (L >= 8 * 8) return false;
        const int pm = L & 7, q = L >> 3, layer = q >> 2, t = q & 3;
        const char* W = (const char*)(p.wt_kv_() + (size_t)layer * 1024 * 1024); const char* H = (const char*)p.memh_();
        if (t < 2) { u.A = H + (size_t)pm * 256 * DM * 2; u.B = W + (size_t)t * 256 * DM * 2; u.row0 = pm * 256; u.col0 = t * 256; u.aux = layer * 2; }
        else { u.A = W + (size_t)(512 + (t - 2) * 256) * DM * 2; u.B = H + (size_t)pm * 256 * DM * 2; u.row0 = (t - 2) * 256; u.col0 = pm * 256; u.aux = layer * 2 + 1; }
        return true;
    }
};
struct EpiGlu {
    static constexpr bool PERM = true;
    Params p; int layer;
    DI bool operator()(f32x4 (&acc)[2][2][4][2], const Unit& u, int wr, int wc, int fr, int fq) const {
        const float* bg = p.b_glu + (size_t)layer * 512; const int colb = u.col0 + wc * 32 + 8 * fq;
        f32x4 bb[2][2];
#pragma unroll
        for (int bj = 0; bj < 2; ++bj) { bb[bj][0] = *(const f32x4*)(bg + colb + bj * 128); bb[bj][1] = *(const f32x4*)(bg + colb + bj * 128 + 4); }
        const bf16_t* zp = p.zbuf_(); bf16_t* gp = p.pc(1);
#pragma unroll
        for (int ai = 0; ai < 2; ++ai) {
            u32x4 zv[4][2], gv[4][2];
#pragma unroll
            for (int m = 0; m < 4; ++m)
#pragma unroll
                for (int bj = 0; bj < 2; ++bj) { const size_t o = (size_t)(u.row0 + ai * 128 + wr * 64 + m * 16 + fr) * 512 + colb + bj * 128; zv[m][bj] = *(const u32x4*)(zp + o); gv[m][bj] = *(const u32x4*)(gp + o); }
#pragma unroll
            for (int m = 0; m < 4; ++m)
#pragma unroll
                for (int bj = 0; bj < 2; ++bj) { const size_t o = (size_t)(u.row0 + ai * 128 + wr * 64 + m * 16 + fr) * 512 + colb + bj * 128; float z[8], g[8]; unpack8(zv[m][bj], z); unpack8(gv[m][bj], g);
                    const f32x4& v0 = acc[ai][bj][m][0]; const f32x4& v1 = acc[ai][bj][m][1]; f32x4 o0, o1;
#pragma unroll
                    for (int j = 0; j < 4; ++j) { o0[j] = z[j] * sigmoidf_(v0[j] + bb[bj][0][j]) * siluf_(g[j]); o1[j] = z[4 + j] * sigmoidf_(v1[j] + bb[bj][1][j]) * siluf_(g[4 + j]); }
                    *(u32x4*)(gp + o) = pack8(o0, o1); }
        }
        return true;
    }
};
struct SchedGlu {
    Params p; int layer, G, c;
    DI bool next(int i, Unit& u) const {
        const int L = i * G + c; if (L >= (TS / 256) * 2) return false;
        const int pm = L >> 1, pn = L & 1;
        u.A = (const char*)(p.zbuf_() + (size_t)pm * 256 * 512); u.B = (const char*)(p.wt_glu_() + (size_t)layer * 512 * 512 + (size_t)pn * 256 * 512); u.row0 = pm * 256; u.col0 = pn * 256; u.aux = 0;
        return true;
    }
};
struct EpiMerge {
    static constexpr bool PERM = true;
    const bf16_t* gates; bf16_t* merged;
    DI bool operator()(f32x4 (&acc)[2][2][4][2], const Unit& u, int wr, int wc, int fr, int fq) const {
        const int n = u.aux; const bool lastn = (n == 3); const bf16_t* g0p = gates + (size_t)n * TS * 1024; const int colb = u.col0 + wc * 32 + 8 * fq;
        u32x4 gv[2][4][2];
#pragma unroll
        for (int ai = 0; ai < 2; ++ai)
#pragma unroll
            for (int m = 0; m < 4; ++m)
#pragma unroll
                for (int bj = 0; bj < 2; ++bj) gv[ai][m][bj] = *(const u32x4*)(g0p + (size_t)(u.row0 + ai * 128 + wr * 64 + m * 16 + fr) * 1024 + colb + bj * 128);
#pragma unroll
        for (int ai = 0; ai < 2; ++ai)
#pragma unroll
            for (int m = 0; m < 4; ++m)
#pragma unroll
                for (int bj = 0; bj < 2; ++bj) { float a[8]; unpack8(gv[ai][m][bj], a); f32x4& v0 = acc[ai][bj][m][0]; f32x4& v1 = acc[ai][bj][m][1];
#pragma unroll
                    for (int j = 0; j < 4; ++j) { v0[j] *= a[j]; v1[j] *= a[4 + j]; }
                    if (lastn) { *(u32x4*)(merged + (size_t)(u.row0 + ai * 128 + wr * 64 + m * 16 + fr) * 1024 + colb + bj * 128) = pack8(v0, v1); v0 = (f32x4){0.f, 0.f, 0.f, 0.f}; v1 = (f32x4){0.f, 0.f, 0.f, 0.f}; } }
        return false;
    }
};
struct SchedMerge {
    Params p; int layer, G, c;
    DI bool next(int i, Unit& u) const {
        const int ti = i >> 2, n = i & 3; const int L = ti * G + c; if (L >= (TS / 256) * 4) return false;
        int pm, pn; pg8::tile_of(L, TS / 256, 4, pm, pn);
        const bf16_t* A = n == 0 ? p.pc(1) : p.pc(12 + n);
        u.A = (const char*)(A + (size_t)pm * 256 * 512); u.B = (const char*)(p.wt_br_() + ((size_t)(layer * 4 + n) * 1024 + (size_t)pn * 256) * 512); u.row0 = pm * 256; u.col0 = pn * 256; u.aux = n;
        return true;
    }
};
struct EpiOut {
    static constexpr bool PERM = false;
    const float* xin; float* xout;
    DI bool operator()(f32x4 (&acc)[2][2][4][2], const Unit& u, int wr, int wc, int fr, int fq) const {
#pragma unroll
        for (int ai = 0; ai < 2; ++ai) { f32x4 xv[4][2][2];
#pragma unroll
            for (int m = 0; m < 4; ++m)
#pragma unroll
                for (int bj = 0; bj < 2; ++bj)
#pragma unroll
                    for (int n = 0; n < 2; ++n) xv[m][bj][n] = *(const f32x4*)(xin + (size_t)(u.row0 + ai * 128 + wr * 64 + m * 16 + fr) * 1024 + u.col0 + wc * 32 + 4 * fq + bj * 128 + n * 16);
#pragma unroll
            for (int m = 0; m < 4; ++m)
#pragma unroll
                for (int bj = 0; bj < 2; ++bj)
#pragma unroll
                    for (int n = 0; n < 2; ++n) *(f32x4*)(xout + (size_t)(u.row0 + ai * 128 + wr * 64 + m * 16 + fr) * 1024 + u.col0 + wc * 32 + 4 * fq + bj * 128 + n * 16) = xv[m][bj][n] + acc[ai][bj][m][n];
        }
        return true;
    }
};
struct SchedOut {
    Params p; int layer, G, c; const bf16_t* hb;
    DI bool next(int i, Unit& u) const {
        const int L = i * G + c; if (L >= (TS / 256) * 4) return false;
        int pm, pn; pg8::tile_of(L, TS / 256, 4, pm, pn);
        u.A = (const char*)(hb + (size_t)pm * 256 * 1024); u.B = (const char*)(p.wt_out_() + ((size_t)layer * 1024 + (size_t)pn * 256) * 1024); u.row0 = pm * 256; u.col0 = pn * 256; u.aux = 0;
        return true;
    }
};
DI int win_row(int cidx) {
    if (cidx < 6144) { const int piece = cidx >> 9, lc = cidx & 511, tile = lc >> 8, l = lc & 255;
        if (piece == 2 || piece == 3) { const int head = l >> 7, d = l & 127, bj = d >> 6, rem = d & 63; return (cidx & ~255) + 128 * bj + 32 * (2 * head + (rem >> 5)) + (rem & 31); }
        if (piece == 6 || piece == 7) { const int un = l >> 6, d = l & 63; return (cidx & ~255) + 128 * (d >> 5) + 32 * un + (d & 31); }
        (void)tile; return cidx; }
    const int n = (cidx - 6144) >> 10, d = (cidx - 6144) & 1023, tile = d >> 6, dd = d & 63;
    return 6144 + tile * 256 + 128 * (n >> 1) + 32 * (dd >> 4) + 8 * ((dd & 15) >> 2) + 4 * (n & 1) + (dd & 3); }
template <bool WIN>
DI void transpose_job(LAS float* tl, const float* src, bf16_t* dst, int R, int C, const float* scale, int& tctr) {
    const int ntr = R / 64, ntc = C / 64, nt = ntr * ntc, G = (int)gridDim.x; const int tid_ = opaque_tid(); const int tx = tid_ & 63, ty = tid_ >> 6;
    const int first = ((int)blockIdx.x - (tctr % G) + G) % G;
    tctr += nt;
    for (int t0 = first; t0 < nt; t0 += 4 * G) {
        __syncthreads();
#pragma unroll
        for (int k = 0; k < 4; ++k) { const int t = t0 + k * G; if (t < nt) { const int tr = t / ntc, tc = t - tr * ntc; LAS float* tk = tl + k * (64 * 65);
#pragma unroll
            for (int i = 0; i < 8; ++i) { const int r = ty + 8 * i; float v = src[(size_t)(tr * 64 + r) * C + tc * 64 + tx]; if (scale) v *= scale[tr * 64 + r]; tk[r * 65 + tx] = v; } } }
        __syncthreads();
#pragma unroll
        for (int k = 0; k < 4; ++k) { const int t = t0 + k * G; if (t < nt) { const int tr = t / ntc, tc = t - tr * ntc; const LAS float* tk = tl + k * (64 * 65);
#pragma unroll
            for (int i = 0; i < 8; ++i) { const int cc = ty + 8 * i; const int drow = WIN ? win_row(tc * 64 + cc) : tc * 64 + cc; dst[(size_t)drow * R + tr * 64 + tx] = f2bf(tk[tx * 65 + cc]); } } }
    }
}

DI void phase_prep(const Params& p, LAS unsigned char* lds) {
    LAS float* tl = (LAS float*)lds; int tctr = 0;
    for (int l = 0; l < DEPTH; ++l) {
        transpose_job<true>(tl, p.w_in + (size_t)l * DM * INC, p.wt_in_() + (size_t)l * INC * DM, DM, INC, p.norm_g + l * DM, tctr);
        transpose_job<false>(tl, p.w_glu + (size_t)l * 512 * 512, p.wt_glu_() + (size_t)l * 512 * 512, 512, 512, nullptr, tctr);
        for (int n = 0; n < 4; ++n) transpose_job<false>(tl, p.w_branch + (size_t)(l * 4 + n) * 512 * 1024, p.wt_br_() + (size_t)(l * 4 + n) * 1024 * 512, 512, 1024, nullptr, tctr);
        transpose_job<false>(tl, p.w_out + (size_t)l * DM * DM, p.wt_out_() + (size_t)l * DM * DM, DM, DM, nullptr, tctr);
        transpose_job<false>(tl, p.w_mem_kv + (size_t)l * DM * DM, p.wt_kv_() + (size_t)l * DM * DM, DM, DM, p.mem_norm_g + l * DM, tctr);
    }
    const long gtid = (long)blockIdx.x * 512 + opaque_tid(), gn = (long)gridDim.x * 512;
    for (long i = gtid; i < (long)SEQ * 32; i += gn) { const int pos = (int)(i >> 5), d = (int)(i & 31);
        const float inv = (float)exp(-(double)(2 * d) / 64.0 * 9.210340371976184); const float ang = (float)pos * inv; float s, c; sincosf(ang, &s, &c); p.dcos_()[i] = c; p.dsin_()[i] = s; }
    for (long i = gtid; i < (long)SEQ * 64; i += gn) { const int pos = (int)(i >> 6), d = (int)(i & 63);
        const float lin = (float)d / 63.0f; const float inv = 1.0f / (float)exp((double)lin * 9.210340371976184); const float ang = (float)pos * inv; float s, c; sincosf(ang, &s, &c);
        p.rcos_()[i] = c; p.rsin_()[i] = s; p.rcosT_()[(size_t)d * SEQ + pos] = c; p.rsinT_()[(size_t)d * SEQ + pos] = s; }
    for (long i = gtid; i < (long)DEPTH * 32 * 64; i += gn) { const int pp = (int)(i & 63), g = (int)((i >> 6) & 31), l = (int)(i >> 11);
        const float lr = fminf(p.lam_re[i], -1e-4f), li = p.lam_im[i], dt = expf(p.log_dt[l * 32 + g]);
        const float mag = expf(lr * dt); float sn, cs; sincosf(li * dt, &sn, &cs); const float are = mag * cs, aim = mag * sn;
        const float nr = are - 1.0f, ni = aim, den = lr * lr + li * li; const float fre = (nr * lr + ni * li) / den, fim = (ni * lr - nr * li) / den;
        p.abar_()[i * 2] = are; p.abar_()[i * 2 + 1] = aim;
        bf16_t* bb = p.bbar_() + ((size_t)(l * 32 + g) * 128) * 16; const float* br = p.b_re + i * 16; const float* bi = p.b_im + i * 16;
        for (int hch = 0; hch < 16; ++hch) { bb[(size_t)pp * 16 + hch] = f2bf(fre * br[hch] - fim * bi[hch]); bb[(size_t)(64 + pp) * 16 + hch] = f2bf(fre * bi[hch] + fim * br[hch]); }
        bf16_t* cc = p.cct_() + ((size_t)(l * 32 + g) * 16) * 128;
        for (int hch = 0; hch < 16; ++hch) { const size_t ci = ((size_t)(l * 32 + g) * 16 + hch) * 64 + pp; cc[hch * 128 + pp] = f2bf(p.c_re[ci]); cc[hch * 128 + 64 + pp] = f2bf(-p.c_im[ci]); }
    }
    if (blockIdx.x == 0 && threadIdx.x < 64) { const int lane = threadIdx.x; float* sc = (float*)(p.wsb + O_CTR + 4096);
        for (int l = 0; l < DEPTH; ++l) { const float lam_init = l == 0 ? 0.2f : 0.35550906759096926f;
            float s1 = p.lq1[l * 64 + lane] * p.lk1[l * 64 + lane], s2 = p.lq2[l * 64 + lane] * p.lk2[l * 64 + lane]; s1 = wave_sum(s1); s2 = wave_sum(s2);
            const float mdq = wave_max(fabsf(p.dq_g[l * 64 + lane])), mdk = wave_max(fabsf(p.dk_g[l * 64 + lane]));
            const float mmq = wave_max(fmaxf(fabsf(p.mq_g[l * 128 + lane]), fabsf(p.mq_g[l * 128 + 64 + lane]))), mmk = wave_max(fmaxf(fabsf(p.mk_g[l * 128 + lane]), fabsf(p.mk_g[l * 128 + 64 + lane])));
            if (lane == 0) { sc[l * 8] = expf(s1) - expf(s2) + lam_init; sc[l * 8 + 1] = -8.0f * mdq * mdk * 1.4426950408889634f; sc[l * 8 + 2] = -11.313708498984761f * mmq * mmk * 1.4426950408889634f; } } }
    { const int tid_ = opaque_tid(); const int wv = (blockIdx.x * 8 + (tid_ >> 6)), nwv = gridDim.x * 8, lane = tid_ & 63;
      for (int r = wv; r < NBATCH * MEML; r += nwv) { const float* s = p.mem + (size_t)r * DM; f32x4 v[4]; float ss = 0.f;
#pragma unroll
          for (int i = 0; i < 4; ++i) { v[i] = *(const f32x4*)(s + i * 256 + lane * 4); ss += v[i][0] * v[i][0] + v[i][1] * v[i][1] + v[i][2] * v[i][2] + v[i][3] * v[i][3]; }
          ss = wave_sum(ss); const float rs = rsqrtf(ss * (1.0f / DM) + EPSN);
#pragma unroll
          for (int i = 0; i < 4; ++i) { u32x2 w; w.x = pk2(v[i][0] * rs, v[i][1] * rs); w.y = pk2(v[i][2] * rs, v[i][3] * rs); *(u32x2*)(p.memh_() + (size_t)r * DM + i * 256 + lane * 4) = w; } } }
}

DI void phase_norm(const Params& p, const float* xs, bf16_t* hp) {
    const int tid_ = opaque_tid(); const int wv = (blockIdx.x * 8 + (tid_ >> 6)), nwv = gridDim.x * 8, lane = tid_ & 63;
    for (int r0 = wv * 4; r0 < TS; r0 += nwv * 4) { f32x4 v[4][4];
#pragma unroll
        for (int q = 0; q < 4; ++q)
#pragma unroll
            for (int i = 0; i < 4; ++i) v[q][i] = *(const f32x4*)(xs + (size_t)(r0 + q) * DM + i * 256 + lane * 4);
#pragma unroll
        for (int q = 0; q < 4; ++q) { float ss = 0.f;
#pragma unroll
            for (int i = 0; i < 4; ++i) ss += v[q][i][0] * v[q][i][0] + v[q][i][1] * v[q][i][1] + v[q][i][2] * v[q][i][2] + v[q][i][3] * v[q][i][3];
            ss = wave_sum(ss); const float rs = rsqrtf(ss * (1.0f / DM) + EPSN);
#pragma unroll
            for (int i = 0; i < 4; ++i) { u32x2 w; w.x = pk2(v[q][i][0] * rs, v[q][i][1] * rs); w.y = pk2(v[q][i][2] * rs, v[q][i][3] * rs); *(u32x2*)(hp + (size_t)(r0 + q) * DM + i * 256 + lane * 4) = w; } }
    }
}
DI void phase_mknorm(const Params& p) {
    const long gtid = (long)blockIdx.x * 512 + opaque_tid(), gn = (long)gridDim.x * 512;
    for (long i = gtid; i < (long)DEPTH * 2048 * 4 * 16; i += gn) { const int sub = (int)(i & 15); const long rh = i >> 4; const int hd = (int)(rh & 3); const long row = rh >> 2; const int l = (int)(row / 2048);
        bf16_t* ptr = p.mk_() + (size_t)row * 512 + hd * 128 + sub * 8; float f[8]; unpack8(*(const u32x4*)ptr, f); float ss = 0.f;
#pragma unroll
        for (int j = 0; j < 8; ++j) ss += f[j] * f[j];
        ss += shx(ss, 1); ss += shx(ss, 2); ss += shx(ss, 4); ss += shx(ss, 8);
        const float rs = rsqrtf(ss * (1.0f / 128.0f) + EPSN); const float* g = p.mk_g + l * 128 + sub * 8; f32x4 o0, o1;
#pragma unroll
        for (int j = 0; j < 4; ++j) { o0[j] = f[j] * rs * g[j]; o1[j] = f[4 + j] * rs * g[4 + j]; }
        *(u32x4*)ptr = pack8(o0, o1); }
}
DI void phase_rope(const Params& p, int layer) {
    const long gtid = (long)blockIdx.x * 512 + opaque_tid(), gn = (long)gridDim.x * 512;
    for (long i = gtid; i < (long)TS * 32; i += gn) { const int dg = (int)(i & 7), hd = (int)((i >> 3) & 3); const long t = i >> 5; const int pos = (int)(t & (SEQ - 1));
        const f32x4 c0 = *(const f32x4*)(p.rcos_() + (size_t)pos * 64 + dg * 8), c1 = *(const f32x4*)(p.rcos_() + (size_t)pos * 64 + dg * 8 + 4);
        const f32x4 s0 = *(const f32x4*)(p.rsin_() + (size_t)pos * 64 + dg * 8), s1 = *(const f32x4*)(p.rsin_() + (size_t)pos * 64 + dg * 8 + 4);
#pragma unroll
        for (int which = 0; which < 2; ++which) { bf16_t* base = p.pc(2 + which) + (size_t)t * 512 + hd * 128 + dg * 8; const float sc = which ? 0.08838834764831845f : 1.0f;
            float a[8], b[8]; unpack8(*(const u32x4*)base, a); unpack8(*(const u32x4*)(base + 64), b); f32x4 o0, o1, q0, q1;
#pragma unroll
            for (int j = 0; j < 4; ++j) { o0[j] = (a[j] * c0[j] - b[j] * s0[j]) * sc; q0[j] = (b[j] * c0[j] + a[j] * s0[j]) * sc; o1[j] = (a[4 + j] * c1[j] - b[4 + j] * s1[j]) * sc; q1[j] = (b[4 + j] * c1[j] + a[4 + j] * s1[j]) * sc; }
            *(u32x4*)base = pack8(o0, o1); *(u32x4*)(base + 64) = pack8(q0, q1); } }
    for (long i = gtid; i < (long)4 * 64 * (TS / 8); i += gn) { const long tg = i % (TS / 8); const int d = (int)((i / (TS / 8)) & 63), hd = (int)(i / ((long)(TS / 8) * 64));
        const long t0 = tg * 8; const int pos0 = (int)(t0 & (SEQ - 1));
        const f32x4 c0 = *(const f32x4*)(p.rcosT_() + (size_t)d * SEQ + pos0), c1 = *(const f32x4*)(p.rcosT_() + (size_t)d * SEQ + pos0 + 4);
        const f32x4 s0 = *(const f32x4*)(p.rsinT_() + (size_t)d * SEQ + pos0), s1 = *(const f32x4*)(p.rsinT_() + (size_t)d * SEQ + pos0 + 4);
        const float lg2 = log2f(1.0f - exp2f(-5.0f - (float)hd)); bf16_t* base = p.pt(0) + (size_t)(hd * 128 + d) * TS + t0;
        float a[8], b[8]; unpack8(*(const u32x4*)base, a); unpack8(*(const u32x4*)(base + (size_t)64 * TS), b); f32x4 o0, o1, q0, q1;
#pragma unroll
        for (int j = 0; j < 4; ++j) { const float k0 = 0.08838834764831845f * exp2f(lg2 * (float)(63 - ((pos0 + j) & 63))), k1 = 0.08838834764831845f * exp2f(lg2 * (float)(63 - ((pos0 + 4 + j) & 63)));
            o0[j] = (a[j] * c0[j] - b[j] * s0[j]) * k0; q0[j] = (b[j] * c0[j] + a[j] * s0[j]) * k0; o1[j] = (a[4 + j] * c1[j] - b[4 + j] * s1[j]) * k1; q1[j] = (b[4 + j] * c1[j] + a[4 + j] * s1[j]) * k1; }
        *(u32x4*)base = pack8(o0, o1); *(u32x4*)(base + (size_t)64 * TS) = pack8(q0, q1); }
    for (long i = gtid; i < (long)TS * 8 * 2 * 4; i += gn) { const int sub = (int)(i & 3); const long r = i >> 2; const int which = (int)(r & 1); const long r2 = r >> 1; const int un = (int)(r2 & 7); const long t = r2 >> 3; const int pos = (int)(t & (SEQ - 1));
        bf16_t* base = p.pc(6 + which) + (size_t)t * 512 + un * 64 + sub * 8; const float* g = (which ? p.dk_g : p.dq_g) + layer * 64 + sub * 8;
        float a[8], b[8]; unpack8(*(const u32x4*)base, a); unpack8(*(const u32x4*)(base + 32), b); float ss = 0.f;
#pragma unroll
        for (int j = 0; j < 8; ++j) ss += a[j] * a[j] + b[j] * b[j];
        ss += shx(ss, 1); ss += shx(ss, 2); const float rs = rsqrtf(ss * (1.0f / 64.0f) + EPSN) * (which ? 1.0f : 0.125f);
        const f32x4 c0 = *(const f32x4*)(p.dcos_() + (size_t)pos * 32 + sub * 8), c1 = *(const f32x4*)(p.dcos_() + (size_t)pos * 32 + sub * 8 + 4);
        const f32x4 s0 = *(const f32x4*)(p.dsin_() + (size_t)pos * 32 + sub * 8), s1 = *(const f32x4*)(p.dsin_() + (size_t)pos * 32 + sub * 8 + 4);
        f32x4 o0, o1, q0, q1;
#pragma unroll
        for (int j = 0; j < 4; ++j) { const float x0 = a[j] * rs * g[j], y0 = b[j] * rs * g[32 + j], x1 = a[4 + j] * rs * g[4 + j], y1 = b[4 + j] * rs * g[36 + j];
            o0[j] = x0 * c0[j] - y0 * s0[j]; q0[j] = y0 * c0[j] + x0 * s0[j]; o1[j] = x1 * c1[j] - y1 * s1[j]; q1[j] = y1 * c1[j] + x1 * s1[j]; }
        *(u32x4*)base = pack8(o0, o1); *(u32x4*)(base + 32) = pack8(q0, q1); }
}
#define MFMA32(a, b, c) __builtin_amdgcn_mfma_f32_32x32x16_bf16((a), (b), (c), 0, 0, 0)
#define MFMA16(a, b, c) __builtin_amdgcn_mfma_f32_16x16x32_bf16((a), (b), (c), 0, 0, 0)
DI int pi32(int r) { return (r & ~12) | ((r & 4) << 1) | ((r & 8) >> 1); }
DI int crow(int reg, int h) { return (reg & 3) + 8 * (reg >> 2) + 4 * h; }
DI bf16x8 pack_regs(const f32x16& x, int s) { u32x4 w; w.x = pk2(x[8 * s], x[8 * s + 1]); w.y = pk2(x[8 * s + 2], x[8 * s + 3]); w.z = pk2(x[8 * s + 4], x[8 * s + 5]); w.w = pk2(x[8 * s + 6], x[8 * s + 7]); return __builtin_bit_cast(bf16x8, w); }
DI void glds16(const void* g, LAS unsigned char* l) { __builtin_amdgcn_global_load_lds((const unsigned*)g, (LAS unsigned*)l, 16, 0, 0); }

template <int NMAP>
DI void attn_item(LAS unsigned char* lds, const bf16_t* Qr, const float* qg, const bf16_t* Kg, int ldk, const bf16_t* Vtg, int ldv,
                  int ntiles, int wnt_base, float nshift, const bf16_t* gate, bf16_t* outp, const float* hn_g, float lam, float oscale) {
    constexpr int DHM = 128 / NMAP, NKS = DHM / 16;
    const int tid = opaque_tid(), w = __builtin_amdgcn_readfirstlane(tid >> 6), lane = tid & 63, r = lane & 31, h = lane >> 5;
    const int wnt = wnt_base + (NMAP == 2 ? (w >> 1) : 0);
    bf16x8 qf[NMAP][NKS];
    { const bf16_t* qrow = Qr + (size_t)(32 * w + r) * 512;
#pragma unroll
      for (int m = 0; m < NMAP; ++m)
#pragma unroll
          for (int ks = 0; ks < NKS; ++ks) qf[m][ks] = *(const bf16x8*)(qrow + m * DHM + 16 * ks + 8 * h);
      if (NMAP == 1) { float ss = 0.f;
#pragma unroll
          for (int ks = 0; ks < NKS; ++ks) { float f[8]; unpack8(__builtin_bit_cast(u32x4, qf[0][ks]), f);
#pragma unroll
              for (int j = 0; j < 8; ++j) ss += f[j] * f[j]; }
          ss += shx(ss, 32); const float rs = rsqrtf(ss * (1.0f / 128.0f) + EPSN) * 0.08838834764831845f;
#pragma unroll
          for (int ks = 0; ks < NKS; ++ks) { float f[8]; unpack8(__builtin_bit_cast(u32x4, qf[0][ks]), f); const float* g = qg + 16 * ks + 8 * h; f32x4 a, b;
#pragma unroll
              for (int j = 0; j < 4; ++j) { a[j] = f[j] * rs * g[j]; b[j] = f[4 + j] * rs * g[4 + j]; }
              qf[0][ks] = __builtin_bit_cast(bf16x8, pack8(a, b)); } } }
    LAS unsigned char* q1l = lds + 65536 + w * 4096 + lane * 16;
    if (NMAP == 2) {
#pragma unroll
        for (int ks = 0; ks < NKS; ++ks) *(LAS bf16x8*)(q1l + ks * 1024) = qf[NMAP - 1][ks];
    }
    f32x16 o[NMAP][4]; float l[NMAP];
#pragma unroll
    for (int m = 0; m < NMAP; ++m) { l[m] = 0.f;
#pragma unroll
        for (int d = 0; d < 4; ++d)
#pragma unroll
            for (int i = 0; i < 16; ++i) o[m][d][i] = 0.f; }
    unsigned ksrc[2], vsrc[2];
#pragma unroll
    for (int i = 0; i < 2; ++i) { const int slot = 2 * w + i; const int kr = 4 * slot + (lane >> 4), kc = (lane & 15) ^ (kr & 15); ksrc[i] = (unsigned)(kr * ldk * 2 + kc * 16);
        const int vr = 8 * slot + (lane >> 3), vc = (lane & 7) ^ ((vr >> 1) & 7); vsrc[i] = (unsigned)(vr * ldv * 2 + vc * 16); }
    const char* kgb = (const char*)Kg; const char* vgb = (const char*)Vtg;
#define ATT_STAGE(kt, buf) do { const char* kp_ = kgb + (size_t)(kt) * 64 * ldk * 2; const char* vp_ = vgb + (size_t)(kt) * 128; \
        _Pragma("unroll") for (int i_ = 0; i_ < 2; ++i_) { glds16(kp_ + ksrc[i_], lds + (buf) * 16384 + (2 * w + i_) * 1024); glds16(vp_ + vsrc[i_], lds + 32768 + (buf) * 16384 + (2 * w + i_) * 1024); } } while (0)
    const int pr = pi32(r); const unsigned kbase = (unsigned)pr * 256u, kx = (unsigned)((pr & 15) ^ h) << 4;
    const unsigned vbase = (unsigned)r * 128u, vx = (unsigned)(((r >> 1) & 7) ^ h) << 4;
    ATT_STAGE(0, 0);
    for (int kt = 0; kt < ntiles; ++kt) {
        asm volatile("s_waitcnt vmcnt(0)" ::: "memory"); __builtin_amdgcn_s_barrier(); asm volatile("" ::: "memory");
        if (kt + 1 < ntiles) ATT_STAGE(kt + 1, (kt + 1) & 1);
        if (kt < wnt) {
            LAS unsigned char* kb = lds + (kt & 1) * 16384; LAS unsigned char* vb = lds + 32768 + (kt & 1) * 16384;
#pragma unroll 1
            for (int kb2 = 0; kb2 < 2; ++kb2) {
                bf16x8 pf[NMAP][2];
#pragma unroll
                for (int m = 0; m < NMAP; ++m) {
                    f32x16 s;
#pragma unroll
                    for (int i = 0; i < 16; ++i) s[i] = 0.f;
#pragma unroll
                    for (int ks = 0; ks < NKS; ++ks) { const unsigned c = (unsigned)(m * (DHM / 8) + 2 * ks) << 4;
                        const bf16x8 a = *(const LAS bf16x8*)(kb + kb2 * 8192 + kbase + (kx ^ c)); const bf16x8 qb_ = (NMAP == 2 && m == 1) ? *(const LAS bf16x8*)(q1l + ks * 1024) : qf[0][ks]; s = MFMA32(a, qb_, s); }
#pragma unroll
                    for (int i = 0; i < 16; ++i) { const float pv = __builtin_amdgcn_exp2f(fmaf(s[i], 1.4426950408889634f, nshift)); s[i] = pv; l[m] += pv; }
                    pf[m][0] = pack_regs(s, 0); pf[m][1] = pack_regs(s, 1);
                }
#pragma unroll
                for (int s2 = 0; s2 < 2; ++s2) { const unsigned c = (unsigned)(4 * kb2 + 2 * s2) << 4;
#pragma unroll
                    for (int d = 0; d < 4; ++d) { const bf16x8 a = *(const LAS bf16x8*)(vb + d * 4096 + vbase + (vx ^ c));
#pragma unroll
                        for (int m = 0; m < NMAP; ++m) o[m][d] = MFMA32(a, pf[m][s2], o[m][d]); } }
            }
        }
    }
#undef ATT_STAGE
    float inv[NMAP];
#pragma unroll
    for (int m = 0; m < NMAP; ++m) { l[m] += shx(l[m], 32); inv[m] = 1.0f / l[m]; }
    float rs; { int ob = __float_as_int(oscale); asm volatile("" : "+s"(ob)); rs = __int_as_float(ob); }
    if (NMAP == 2) { float ss = 0.f;
#pragma unroll
        for (int d = 0; d < 4; ++d)
#pragma unroll
            for (int i = 0; i < 16; ++i) { const float v = o[0][d][i] * inv[0] - lam * o[NMAP - 1][d][i] * inv[NMAP - 1]; o[0][d][i] = v; ss += v * v; }
        ss += shx(ss, 32); rs *= rsqrtf(ss * (1.0f / 128.0f) + EPSN);
    } else {
#pragma unroll
        for (int d = 0; d < 4; ++d)
#pragma unroll
            for (int i = 0; i < 16; ++i) o[0][d][i] *= inv[0];
    }
    const int tid2 = opaque_tid(); const size_t rowo = (size_t)(32 * (tid2 >> 6) + (tid2 & 31)) * 512; const bf16_t* grow = gate + rowo; bf16_t* orow = outp + rowo;
    u32x2 gwv[4][4]; f32x4 hgv[4][4];
#pragma unroll
    for (int d = 0; d < 4; ++d)
#pragma unroll
        for (int gq = 0; gq < 4; ++gq) { const int dv = 32 * d + 8 * gq + 4 * h; gwv[d][gq] = *(const u32x2*)(grow + dv); if (NMAP == 2) hgv[d][gq] = *(const f32x4*)(hn_g + dv); }
#pragma unroll
    for (int d = 0; d < 4; ++d)
#pragma unroll
        for (int gq = 0; gq < 4; ++gq) { const int dv = 32 * d + 8 * gq + 4 * h; const u32x2 gw = gwv[d][gq];
            const float g0 = lo2f(gw.x), g1 = hi2f(gw.x), g2 = lo2f(gw.y), g3 = hi2f(gw.y); float e0 = rs, e1 = rs, e2 = rs, e3 = rs;
            if (NMAP == 2) { const f32x4 hg = hgv[d][gq]; e0 *= hg[0]; e1 *= hg[1]; e2 *= hg[2]; e3 *= hg[3]; }
            u32x2 ow; ow.x = pk2(o[0][d][4 * gq] * e0 * siluf_(g0), o[0][d][4 * gq + 1] * e1 * siluf_(g1)); ow.y = pk2(o[0][d][4 * gq + 2] * e2 * siluf_(g2), o[0][d][4 * gq + 3] * e3 * siluf_(g3));
            *(u32x2*)(orow + dv) = ow; }
    __builtin_amdgcn_s_barrier();
}
#ifndef TEST_ZFILL
#define TEST_ZFILL 0
#endif
DI void ret_item(LAS unsigned char* lds, const bf16_t* Qg, const bf16_t* Kg, const bf16_t* Ktg, const bf16_t* Vtg, const bf16_t* gate, bf16_t* outp, int hd) {
    const int tid = opaque_tid(), w = __builtin_amdgcn_readfirstlane(tid >> 6), lane = tid & 63, r = lane & 31, h = lane >> 5;
    const float lg2 = log2f(1.0f - exp2f(-5.0f - (float)hd)); const float cdec = exp2f(64.0f * lg2);
    size_t qsrc[2], tsrc[2];
#pragma unroll
    for (int i = 0; i < 2; ++i) { const int slot = 2 * w + i; const int kr = 4 * slot + (lane >> 4), kc = (lane & 15) ^ (kr & 15); qsrc[i] = (size_t)kr * 1024 + kc * 16;
        const int vr = 8 * slot + (lane >> 3), vc = (lane & 7) ^ ((vr >> 1) & 7); tsrc[i] = (size_t)vr * TS * 2 + vc * 16; }
#define RET_STAGE(c, buf) do { const size_t qo = (size_t)(c) * 64 * 1024, to = (size_t)(c) * 128; LAS unsigned char* bb = lds + (buf) * 65536; \
        _Pragma("unroll") for (int i_ = 0; i_ < 2; ++i_) { const int so = (2 * w + i_) * 1024; glds16((const char*)Qg + qo + qsrc[i_], bb + so); glds16((const char*)Kg + qo + qsrc[i_], bb + 16384 + so); \
            glds16((const char*)Ktg + to + tsrc[i_], bb + 32768 + so); glds16((const char*)Vtg + to + tsrc[i_], bb + 49152 + so); } } while (0)
    LAS unsigned char* pimg = lds + 131072; LAS float* red = (LAS float*)(lds + 131072 + 8192);
    f32x16 S[4];
#pragma unroll
    for (int d = 0; d < 4; ++d)
#pragma unroll
        for (int i = 0; i < 16; ++i) S[d][i] = 0.f;
    const int pr = pi32(r);
    const unsigned x16 = (unsigned)((r & 15) ^ h) << 4, x16p = (unsigned)((pr & 15) ^ h) << 4, x8 = (unsigned)(((r >> 1) & 7) ^ h) << 4;
    RET_STAGE(0, 0);
    for (int c = 0; c < SEQ / 64; ++c) {
        if (w < 4) asm volatile("s_waitcnt vmcnt(8)" ::: "memory"); else asm volatile("s_waitcnt vmcnt(0)" ::: "memory");
        __builtin_amdgcn_s_barrier(); asm volatile("" ::: "memory");
        if (c + 1 < SEQ / 64) RET_STAGE(c + 1, (c + 1) & 1);
        LAS unsigned char* qb = lds + (c & 1) * 65536; LAS unsigned char* kb = qb + 16384; LAS unsigned char* ktb = qb + 32768; LAS unsigned char* vtb = qb + 49152;
        if (w < 4) {
            const int jb = w & 1, ib = w >> 1; f32x16 s;
#pragma unroll
            for (int i = 0; i < 16; ++i) s[i] = 0.f;
#pragma unroll
            for (int ks = 0; ks < 8; ++ks) { const unsigned cc = (unsigned)(2 * ks) << 4;
                const bf16x8 a = *(const LAS bf16x8*)(kb + (32 * jb + pr) * 256 + (x16p ^ cc)); const bf16x8 b = *(const LAS bf16x8*)(qb + (32 * ib + r) * 256 + (x16 ^ cc)); s = MFMA32(a, b, s); }
            const int iq = 32 * ib + r;
#pragma unroll
            for (int i = 0; i < 16; ++i) { const int j = 32 * jb + pi32(crow(i, h)); const int dd = iq > j ? iq - j : j - iq; s[i] *= exp2f(lg2 * (float)dd); }
#pragma unroll
            for (int s2 = 0; s2 < 2; ++s2) { const unsigned cc = (unsigned)(4 * jb + 2 * s2) << 4; *(LAS bf16x8*)(pimg + iq * 128 + ((((unsigned)((iq >> 1) & 7) ^ h) << 4) ^ cc)) = pack_regs(s, s2); }
        }
        asm volatile("s_waitcnt lgkmcnt(0)" ::: "memory"); __builtin_amdgcn_s_barrier(); asm volatile("" ::: "memory");
        if (w >= 4) {
#pragma unroll
            for (int i = 0; i < 4; ++i) { const int slot = 4 * (w - 4) + i; const int gr = 4 * slot + (lane >> 4), gc = (lane & 15) ^ (gr & 15);
                glds16((const char*)gate + ((size_t)(c * 64 + gr) * 512) * 2 + gc * 16, kb + slot * 1024); }
        }
        f32x16 o[2];
        if (w < 4) {
            const float qd0 = exp2f(lg2 * (float)(r + 1)), qd1 = exp2f(lg2 * (float)(33 + r));
#pragma unroll
            for (int ib = 0; ib < 2; ++ib)
#pragma unroll
                for (int i = 0; i < 16; ++i) o[ib][i] = 0.f;
#pragma unroll
            for (int d = 0; d < 4; ++d)
#pragma unroll
                for (int s2 = 0; s2 < 2; ++s2) { const bf16x8 a = pack_regs(S[d], s2);
                    const unsigned c0 = (unsigned)(4 * d + 2 * s2), c1 = c0 + 1;
#pragma unroll
                    for (int ib = 0; ib < 2; ++ib) { const int iq = 32 * ib + r; const unsigned sw = (unsigned)(iq & 15);
                        const s16x4 lo = *(const LAS s16x4*)(qb + iq * 256 + ((c0 ^ sw) << 4) + 8 * h); const s16x4 hi = *(const LAS s16x4*)(qb + iq * 256 + ((c1 ^ sw) << 4) + 8 * h);
                        const bf16x8 b = __builtin_shufflevector(lo, hi, 0, 1, 2, 3, 4, 5, 6, 7); o[ib] = MFMA32(a, b, o[ib]); } }
#pragma unroll
            for (int i = 0; i < 16; ++i) { o[0][i] *= qd0; o[1][i] *= qd1; }
            bf16x8 vf[4];
#pragma unroll
            for (int ks = 0; ks < 4; ++ks) vf[ks] = *(const LAS bf16x8*)(vtb + (32 * w + r) * 128 + (x8 ^ ((unsigned)(2 * ks) << 4)));
#pragma unroll
            for (int ib = 0; ib < 2; ++ib) { const int iq = 32 * ib + r;
#pragma unroll
                for (int ks = 0; ks < 4; ++ks) { const bf16x8 b = *(const LAS bf16x8*)(pimg + iq * 128 + (x8 ^ ((unsigned)(2 * ks) << 4))); o[ib] = MFMA32(vf[ks], b, o[ib]); } }
#pragma unroll
            for (int d = 0; d < 4; ++d) {
#pragma unroll
                for (int i = 0; i < 16; ++i) S[d][i] *= cdec;
#pragma unroll
                for (int ks = 0; ks < 4; ++ks) { const bf16x8 a = *(const LAS bf16x8*)(ktb + (32 * d + r) * 128 + (x8 ^ ((unsigned)(2 * ks) << 4))); S[d] = MFMA32(a, vf[ks], S[d]); } }
#pragma unroll
            for (int ib = 0; ib < 2; ++ib) { float ss = 0.f;
#pragma unroll
                for (int i = 0; i < 16; ++i) ss += o[ib][i] * o[ib][i];
                ss += shx(ss, 32); if (h == 0) red[w * 64 + 32 * ib + r] = ss; }
        }
        if (w >= 4) asm volatile("s_waitcnt vmcnt(0)" ::: "memory");
        asm volatile("s_waitcnt lgkmcnt(0)" ::: "memory"); __builtin_amdgcn_s_barrier(); asm volatile("" ::: "memory");
        if (w < 4) {
#pragma unroll
            for (int ib = 0; ib < 2; ++ib) { const int iq = 32 * ib + r; const float tot = red[iq] + red[64 + iq] + red[128 + iq] + red[192 + iq]; const float rs = rsqrtf(tot * (1.0f / 128.0f) + EPSN);
                const bf16_t* grow = gate + (size_t)(c * 64 + iq) * 512 + 32 * w; bf16_t* orow = outp + (size_t)(c * 64 + iq) * 512 + 32 * w;
#pragma unroll
                for (int gq = 0; gq < 4; ++gq) { const int dv = 8 * gq + 4 * h; const u32x2 gw = *(const LAS u32x2*)(kb + iq * 256 + ((((unsigned)(4 * w + gq)) ^ (unsigned)(iq & 15)) << 4) + 8 * h); u32x2 ow;
                    ow.x = pk2(o[ib][4 * gq] * rs * siluf_(lo2f(gw.x)), o[ib][4 * gq + 1] * rs * siluf_(hi2f(gw.x))); ow.y = pk2(o[ib][4 * gq + 2] * rs * siluf_(lo2f(gw.y)), o[ib][4 * gq + 3] * rs * siluf_(hi2f(gw.y)));
                    *(u32x2*)(orow + dv) = ow; } }
        }
    }
#undef RET_STAGE
    __builtin_amdgcn_s_barrier();
}

DI float gelu_tanh(float y) { const float a = 0.7978845608028654f * (y + 0.044715f * y * y * y); const float e = __expf(2.0f * a); return 0.5f * y * (2.0f - 2.0f * __builtin_amdgcn_rcpf(e + 1.0f)); }
DI void s5_item(LAS unsigned char* lds, const Params& p, int layer, int bslab, int g) {
    const int tid_ = opaque_tid(); const int lane = tid_ & 63, w = __builtin_amdgcn_readfirstlane(tid_ >> 6), r = lane & 31, h = lane >> 5, fr = lane & 15, fq = lane >> 4;
    LAS unsigned char* img = lds + w * 8704;
    const int lg = layer * 32 + g;
    bf16x8 bfr[4], cfr[4];
#pragma unroll
    for (int sb = 0; sb < 4; ++sb) bfr[sb] = *(const bf16x8*)(p.bbar_() + ((size_t)lg * 128 + 32 * sb + r) * 16 + 8 * h);
#pragma unroll
    for (int ks = 0; ks < 4; ++ks) cfr[ks] = *(const bf16x8*)(p.cct_() + ((size_t)lg * 16 + fr) * 128 + 32 * ks + 8 * fq);
    const float are = p.abar_()[((size_t)lg * 64 + lane) * 2], aim = p.abar_()[((size_t)lg * 64 + lane) * 2 + 1];
    const f32x4 dsk = *(const f32x4*)(p.ssm_d + layer * 512 + g * 16 + 4 * fq);
    float xr = 0.f, xi = 0.f;
    const bf16_t* ub = p.pc(0) + (size_t)bslab * SEQ * 512 + g * 16; bf16_t* zb = p.zbuf_() + (size_t)bslab * SEQ * 512 + g * 16;
    bf16x8 uf = *(const bf16x8*)(ub + (size_t)r * 512 + 8 * h);
    for (int t0 = 0; t0 < SEQ; t0 += 32) {
        const bf16x8 ucur = uf;
        if (t0 + 32 < SEQ) uf = *(const bf16x8*)(ub + (size_t)(t0 + 32 + r) * 512 + 8 * h);
#pragma unroll
        for (int sb = 0; sb < 4; ++sb) { f32x16 z;
#pragma unroll
            for (int i = 0; i < 16; ++i) z[i] = 0.f;
            z = MFMA32(bfr[sb], ucur, z);
#pragma unroll
            for (int gq = 0; gq < 4; ++gq) { u32x2 wv; wv.x = pk2(z[4 * gq], z[4 * gq + 1]); wv.y = pk2(z[4 * gq + 2], z[4 * gq + 3]); *(LAS u32x2*)(img + r * 272 + (32 * sb + 8 * gq + 4 * h) * 2) = wv; } }
        asm volatile("s_waitcnt lgkmcnt(0)" ::: "memory");
        unsigned short rb[32], ib[32];
#pragma unroll
        for (int t = 0; t < 32; ++t) { LAS bf16_t* row = (LAS bf16_t*)(img + t * 272); rb[t] = row[lane]; ib[t] = row[64 + lane]; }
#pragma unroll
        for (int t = 0; t < 32; ++t) { const float br = bf2f(rb[t]), bi = bf2f(ib[t]);
            const float nr = fmaf(are, xr, fmaf(-aim, xi, br)), ni = fmaf(are, xi, fmaf(aim, xr, bi)); xr = nr; xi = ni; rb[t] = f2bf(xr); ib[t] = f2bf(xi); }
#pragma unroll
        for (int t = 0; t < 32; ++t) { LAS bf16_t* row = (LAS bf16_t*)(img + t * 272); row[lane] = rb[t]; row[64 + lane] = ib[t]; }
        asm volatile("s_waitcnt lgkmcnt(0)" ::: "memory");
#pragma unroll
        for (int tb = 0; tb < 2; ++tb) { f32x4 y = {0.f, 0.f, 0.f, 0.f};
#pragma unroll
            for (int ks = 0; ks < 4; ++ks) { const bf16x8 b = *(const LAS bf16x8*)(img + (16 * tb + fr) * 272 + (32 * ks + 8 * fq) * 2); y = MFMA16(cfr[ks], b, y); }
            const u32x4 uw = __builtin_bit_cast(u32x4, ucur); const int src = 16 * tb + fr + 32 * (fq >> 1);
            const unsigned d0 = shl_u(uw.x, src), d1 = shl_u(uw.y, src), d2 = shl_u(uw.z, src), d3 = shl_u(uw.w, src);
            const unsigned ua = (fq & 1) ? d2 : d0, ubw = (fq & 1) ? d3 : d1;
            const float y0 = y[0] + dsk[0] * lo2f(ua), y1 = y[1] + dsk[1] * hi2f(ua), y2 = y[2] + dsk[2] * lo2f(ubw), y3 = y[3] + dsk[3] * hi2f(ubw);
            u32x2 ow; ow.x = pk2(gelu_tanh(y0), gelu_tanh(y1)); ow.y = pk2(gelu_tanh(y2), gelu_tanh(y3));
            *(u32x2*)(zb + (size_t)(t0 + 16 * tb + fr) * 512 + 4 * fq) = ow; }
    }
}

DI void s5_item_tr(LAS unsigned char* lds, const Params& p, int layer, int bslab, int g, bf16_t* zdst) {
    const int tid_ = opaque_tid(); const int lane = tid_ & 63, w = __builtin_amdgcn_readfirstlane(tid_ >> 6), r = lane & 31, h = lane >> 5, fr = lane & 15, fq = lane >> 4;
    LAS unsigned char* img = lds + w * 10240;
    const int lg = layer * 32 + g;
    bf16x8 bfr[4], cfr[4];
#pragma unroll
    for (int sb = 0; sb < 4; ++sb) bfr[sb] = *(const bf16x8*)(p.bbar_() + ((size_t)lg * 128 + 32 * sb + r) * 16 + 8 * h);
#pragma unroll
    for (int ks = 0; ks < 4; ++ks) cfr[ks] = *(const bf16x8*)(p.cct_() + ((size_t)lg * 16 + fr) * 128 + 32 * ks + 8 * fq);
    const float are = p.abar_()[((size_t)lg * 64 + lane) * 2], aim = p.abar_()[((size_t)lg * 64 + lane) * 2 + 1];
    const f32x4 dsk = *(const f32x4*)(p.ssm_d + layer * 512 + g * 16 + 4 * fq);
    float xr = 0.f, xi = 0.f;
    const bf16_t* ub = p.pc(0) + (size_t)bslab * SEQ * 512 + g * 16; bf16_t* zb = zdst + (size_t)bslab * SEQ * 512 + g * 16;
    bf16x8 uf = *(const bf16x8*)(ub + (size_t)r * 512 + 8 * h);
    typedef __attribute__((address_space(3))) s16x4 lds_s16x4;
    for (int t0 = 0; t0 < SEQ; t0 += 32) {
        const bf16x8 ucur = uf;
        if (t0 + 32 < SEQ) uf = *(const bf16x8*)(ub + (size_t)(t0 + 32 + r) * 512 + 8 * h);
#pragma unroll
        for (int sb = 0; sb < 4; ++sb) { f32x16 z;
#pragma unroll
            for (int i = 0; i < 16; ++i) z[i] = 0.f;
            z = MFMA32(ucur, bfr[sb], z);
#pragma unroll
            for (int gq = 0; gq < 4; ++gq) { u32x2 wv; wv.x = pk2(z[4 * gq], z[4 * gq + 1]); wv.y = pk2(z[4 * gq + 2], z[4 * gq + 3]); *(LAS u32x2*)(img + (32 * sb + r) * 80 + 16 * gq + 8 * h) = wv; } }
        asm volatile("s_waitcnt lgkmcnt(0)" ::: "memory");
        u32x4 rv[4], iv[4];
#pragma unroll
        for (int q = 0; q < 4; ++q) { rv[q] = *(const LAS u32x4*)(img + lane * 80 + 16 * q); iv[q] = *(const LAS u32x4*)(img + (64 + lane) * 80 + 16 * q); }
#pragma unroll
        for (int q = 0; q < 4; ++q)
#pragma unroll
            for (int e = 0; e < 4; ++e) { const unsigned rw = rv[q][e], iw = iv[q][e];
                float nr = fmaf(are, xr, fmaf(-aim, xi, lo2f(rw))), ni = fmaf(are, xi, fmaf(aim, xr, lo2f(iw))); const float r0 = nr, i0 = ni;
                xr = fmaf(are, nr, fmaf(-aim, ni, hi2f(rw))); xi = fmaf(are, ni, fmaf(aim, nr, hi2f(iw)));
                rv[q][e] = pk2(r0, xr); iv[q][e] = pk2(i0, xi); }
#pragma unroll
        for (int q = 0; q < 4; ++q) { *(LAS u32x4*)(img + lane * 80 + 16 * q) = rv[q]; *(LAS u32x4*)(img + (64 + lane) * 80 + 16 * q) = iv[q]; }
        asm volatile("s_waitcnt lgkmcnt(0)" ::: "memory");
#pragma unroll
        for (int tb = 0; tb < 2; ++tb) { f32x4 y = {0.f, 0.f, 0.f, 0.f};
#pragma unroll
            for (int ks = 0; ks < 4; ++ks) { LAS unsigned char* bp = img + (32 * ks + 8 * fq + (fr >> 2)) * 80 + 32 * tb + 8 * (fr & 3);
                const s16x4 lo = __builtin_amdgcn_ds_read_tr16_b64_v4i16((lds_s16x4*)bp), hi = __builtin_amdgcn_ds_read_tr16_b64_v4i16((lds_s16x4*)(bp + 320));
                const bf16x8 b = __builtin_shufflevector(lo, hi, 0, 1, 2, 3, 4, 5, 6, 7); y = MFMA16(cfr[ks], b, y); }
            const u32x4 uw = __builtin_bit_cast(u32x4, ucur); const int src = 16 * tb + fr + 32 * (fq >> 1);
            const unsigned d0 = shl_u(uw.x, src), d1 = shl_u(uw.y, src), d2 = shl_u(uw.z, src), d3 = shl_u(uw.w, src);
            const unsigned ua = (fq & 1) ? d2 : d0, ubw = (fq & 1) ? d3 : d1;
            const float y0 = y[0] + dsk[0] * lo2f(ua), y1 = y[1] + dsk[1] * hi2f(ua), y2 = y[2] + dsk[2] * lo2f(ubw), y3 = y[3] + dsk[3] * hi2f(ubw);
            u32x2 ow; ow.x = pk2(gelu_tanh(y0), gelu_tanh(y1)); ow.y = pk2(gelu_tanh(y2), gelu_tanh(y3));
            *(u32x2*)(zb + (size_t)(t0 + 16 * tb + fr) * 512 + 4 * fq) = ow; }
        asm volatile("s_waitcnt lgkmcnt(0)" ::: "memory");
    }
}
#ifndef TEST_TOL
#define TEST_TOL 0.05f
#endif
#ifndef TEST_MAXBAD
#define TEST_MAXBAD 0u
#endif
#ifndef TEST_TR
#define TEST_TR 2
#endif
#ifndef S5_EXIT
#define S5_EXIT 0
#endif
typedef __attribute__((address_space(4))) const Params CParams;
#if defined(__HIP_DEVICE_COMPILE__)
DI Params load_params() { CParams* kp = (CParams*)__builtin_amdgcn_kernarg_segment_ptr(); asm volatile("" : "+s"(kp)); return *kp; }
#else
DI Params load_params() { return Params{}; }
#endif
DI float rfl(float v) { int i = __builtin_amdgcn_readfirstlane(__float_as_int(v)); asm volatile("" : "+s"(i)); return __int_as_float(i); }
DI void phase_mixers(const Params& p, LAS unsigned char* lds, int layer, int slab, int rep, int mask = 15) {
    const int tid = opaque_tid(), w = __builtin_amdgcn_readfirstlane(tid >> 6);
    const int osb = layer == 0 ? 0x3f4ccccd : 0x3f24fd5c;
    int osb2 = osb; asm volatile("" : "+s"(osb2)); const float oscale_d = __int_as_float(osb2);
    const float* sc = p.scal() + layer * 8; const float lam = rfl(sc[0]), nshift_d = rfl(sc[1]), nshift_m = rfl(sc[2]);
    LAS unsigned* qslot = (LAS unsigned*)(lds + 147440);
    unsigned* ctr = p.ctr_() + (layer * NSLAB + slab) * 256 + rep * 32;
    constexpr int S5W = 4;
    constexpr int N_S5 = SLABB * 32 / S5W, N_RET = SLABB * 4, N_DIFF = SLABB * 4 * 32, N_MEM = SLABB * 4 * 32;
#if STATIC_Q
#define QUEUE_LOOP(CTR, N, ...) for (int item = (int)((blockIdx.x + gridDim.x - (((CTR) - ctr) / 2) % gridDim.x) % gridDim.x); item < (N); item += gridDim.x) { __syncthreads(); __VA_ARGS__ }
#else
#define QUEUE_LOOP(CTR, N, ...) for (;;) { if (tid == 0) *qslot = atomicAdd((CTR), 1u); __syncthreads(); const int item = __builtin_amdgcn_readfirstlane((int)*qslot); __syncthreads(); if (item >= (N)) break; __VA_ARGS__ }
#endif
    bool did_s5 = false;
    if (mask & 1) QUEUE_LOOP(ctr, N_S5, { did_s5 = true;
#if TEST_TR == 1
        if (w < S5W) { const int idx = item * S5W + w; s5_item(lds, p, layer, idx >> 5, idx & 31); } __syncthreads();
        if (w < S5W) { const int idx = item * S5W + w; s5_item_tr(lds, p, layer, idx >> 5, idx & 31, (bf16_t*)(p.wsb + O_END)); } __syncthreads();
#elif TEST_TR == 2
#if TEST_ZFILL
        { const int t2 = opaque_tid(); for (int o = t2 * 16; o < 81920; o += 8192) *(LAS u32x4*)(lds + o) = (u32x4){0u, 0u, 0u, 0u}; __syncthreads(); }
#endif
        if (w < S5W) { const int idx = item * S5W + w; s5_item_tr(lds, p, layer, idx >> 5, idx & 31, p.zbuf_()); } __syncthreads();
#else
        if (w < S5W) { const int idx = item * S5W + w; s5_item(lds, p, layer, idx >> 5, idx & 31); } __syncthreads();
#endif
    })
    if (S5_EXIT && did_s5) return;
    if (mask & 2) QUEUE_LOOP(ctr + 64, N_RET, { const int b = item >> 2, hd = item & 3;
        ret_item(lds, p.pc(2) + (size_t)b * SEQ * 512 + hd * 128, p.pc(3) + (size_t)b * SEQ * 512 + hd * 128, p.pt(0) + (size_t)(hd * 128) * TS + (size_t)b * SEQ,
                 p.pt(1) + (size_t)(hd * 128) * TS + (size_t)b * SEQ, p.pc(5) + (size_t)b * SEQ * 512 + hd * 128, p.pc(13) + (size_t)b * SEQ * 512 + hd * 128, hd); })
    if (mask & 4) QUEUE_LOOP(ctr + 128, N_DIFF, { const int qt = 31 - (item >> 4), b = (item >> 2) & 3, hd = item & 3;
        const size_t qo = ((size_t)b * SEQ + 256 * qt) * 512 + hd * 128;
        attn_item<2>(lds, p.pc(6) + qo, nullptr, p.pc(7) + (size_t)b * SEQ * 512 + hd * 128, 512, p.pt(2) + (size_t)(hd * 128) * TS + (size_t)b * SEQ, TS,
                     4 * qt + 4, 4 * qt + 1, nshift_d, p.pc(9) + qo, p.pc(14) + qo, p.hn_g + layer * 128, lam, oscale_d); })
    if (mask & 8) QUEUE_LOOP(ctr + 192, N_MEM, { const int qt = item >> 4, b = (item >> 2) & 3, hd = item & 3; const int bg = slab * SLABB + b;
        const size_t qo = ((size_t)b * SEQ + 256 * qt) * 512 + hd * 128;
        attn_item<1>(lds, p.pc(10) + qo, p.mq_g + layer * 128, p.mk_() + ((size_t)layer * 2048 + bg * 256) * 512 + hd * 128, 512,
                     p.mvt_() + ((size_t)layer * 512 + hd * 128) * 2048 + bg * 256, 2048, 4, 4, nshift_m, p.pc(11) + qo, p.pc(15) + qo, nullptr, 0.f, 1.0f); })
#undef QUEUE_LOOP
}


#ifndef TIME_REP
#define TIME_REP 0
#endif
#ifndef DBG_MASK
#define DBG_MASK 15
#endif
#ifndef STATIC_Q
#define STATIC_Q 0
#endif
#ifndef DBG_STOP
#define DBG_STOP 0
#endif
DI void dbg_sum(const bf16_t* buf, size_t n, float& acc) {
    const size_t gtid = (size_t)blockIdx.x * 512 + threadIdx.x, gn = (size_t)gridDim.x * 512;
    for (size_t i = gtid; i < n / 4; i += gn) { const u32x2 w = *(const u32x2*)(buf + i * 4); acc += lo2f(w.x) + hi2f(w.x) + lo2f(w.y) + hi2f(w.y); }
}
DI void dbg_finish(const Params& p, float acc) {
    const size_t gtid = (size_t)blockIdx.x * 512 + threadIdx.x, gn = (size_t)gridDim.x * 512;
    for (size_t i = gtid; i < (size_t)NBATCH * SEQ * DM; i += gn) p.out[i] = (i == gtid) ? acc : 0.f;
}
DI void grid_barrier(unsigned* bar, unsigned& gen, unsigned nblk) {
    asm volatile("s_waitcnt vmcnt(0) lgkmcnt(0)" ::: "memory");
    __syncthreads();
    const int t_ = opaque_tid();
    if (__builtin_amdgcn_readfirstlane(t_ >> 6) == 0) {
        __builtin_amdgcn_fence(__ATOMIC_RELEASE, "agent");
        const unsigned target = gen + 1u; unsigned prev = 0u;
        if ((t_ & 63) == 0) prev = __hip_atomic_fetch_add(bar, 1u, __ATOMIC_RELAXED, __HIP_MEMORY_SCOPE_AGENT);
        const unsigned prev_s = (unsigned)__builtin_amdgcn_readfirstlane((int)prev);
        if (prev_s == nblk - 1u) { if ((t_ & 63) == 0) { __hip_atomic_store(bar, 0u, __ATOMIC_RELAXED, __HIP_MEMORY_SCOPE_AGENT); __hip_atomic_store(bar + 64, target, __ATOMIC_RELEASE, __HIP_MEMORY_SCOPE_AGENT); } }
        else if ((t_ & 63) == 0) { while (__hip_atomic_load(bar + 64, __ATOMIC_RELAXED, __HIP_MEMORY_SCOPE_AGENT) < target) __builtin_amdgcn_s_sleep(1); }
        __builtin_amdgcn_fence(__ATOMIC_ACQUIRE, "agent");
    }
    __syncthreads();
    gen += 1u;
}
__global__ void __launch_bounds__(512, 2) fwd_megakernel(Params p_unused) {
    cg::grid_group grid = cg::this_grid();
#define GSYNC() grid_barrier(gbar, gen, (unsigned)G)
    extern __shared__ __attribute__((aligned(16))) unsigned char shm[];
    LAS unsigned char* lds = (LAS unsigned char*)shm;
    const int G = gridDim.x, c = blockIdx.x;
    init_wid_table();
    unsigned gen = 0; unsigned* gbar; { const Params p = load_params(); gbar = (unsigned*)(p.wsb + O_CTR + 6144); }
    { const Params p = load_params(); phase_prep(p, lds); }
    __threadfence(); grid.sync(); __threadfence();
    { const Params p = load_params(); SchedKV S{p, G, c}; EpiKV E{p}; pg8::gemm_phase(lds, 1024, S, E); }
    GSYNC();
#pragma unroll 1
    for (int layer = 0; layer < DEPTH; ++layer) {
        { const Params p = load_params();
#pragma unroll 1
          for (int s_ = 0; s_ < NSLAB; ++s_) { const float* xin = (layer == 0 ? p.x : p.out) + (size_t)s_ * TS * DM; phase_norm(p, xin, p.hs(s_)); }
          if (layer == 0) phase_mknorm(p); }
        GSYNC();
#pragma unroll 1
        for (int slab = 0; slab < NSLAB; ++slab) {
            { const Params p = load_params(); SchedIn S{p, layer, G, c, p.hs(slab)}; EpiIn E{p, layer}; pg8::gemm_phase(lds, 1024, S, E); }
            if (TIME_REP == 1 && layer == 0 && slab == 0) { GSYNC(); const Params p = load_params(); SchedIn S{p, layer, G, c, p.hs(slab)}; EpiIn E{p, layer}; pg8::gemm_phase(lds, 1024, S, E); }
            GSYNC();
            if (DBG_STOP == 1) { const Params p = load_params(); float a_ = 0.f; dbg_sum(p.pcb_(), (size_t)13 * TS * 512, a_); dbg_sum(p.gates_(), (size_t)4 * TS * 1024, a_); dbg_finish(p, a_); return; }
            if (DBG_STOP == 2) { const Params p = load_params(); float a_ = 0.f; dbg_sum(p.pcb_(), (size_t)13 * TS * 512, a_); dbg_finish(p, a_); return; }
            { const Params p = load_params(); phase_mixers(p, lds, layer, slab, 0, DBG_MASK); }
#if TEST_TR == 1
            if (layer == 0 && slab == 0) { GSYNC(); const Params p = load_params(); const bf16_t* za = p.zbuf_(); const bf16_t* zt = (const bf16_t*)(p.wsb + O_END); unsigned bad = 0;
                const size_t gtid = (size_t)blockIdx.x * 512 + opaque_tid(), gn = (size_t)gridDim.x * 512;
                for (size_t i = gtid; i < (size_t)TS * 512; i += gn) { const float a = bf2f(za[i]), b = bf2f(zt[i]); if (!(fabsf(a - b) <= TEST_TOL * (1.0f + fabsf(a)))) ++bad; }
                if (bad) atomicAdd((unsigned*)(p.wsb + O_CTR + 7168), bad); }
#endif
            if (TIME_REP == 2 && layer == 0 && slab == 0) { GSYNC(); const Params p = load_params(); phase_mixers(p, lds, layer, slab, 1); }
            if (TIME_REP >= 4 && TIME_REP <= 7 && layer == 0 && slab == 0) { GSYNC(); const Params p = load_params(); phase_mixers(p, lds, layer, slab, 1, 1 << (TIME_REP - 4)); }
            GSYNC();
            if (DBG_STOP == 3) { const Params p = load_params(); float a_ = 0.f; dbg_sum(p.pcb_(), (size_t)16 * TS * 512, a_); dbg_sum(p.zbuf_(), (size_t)TS * 512, a_); dbg_finish(p, a_); return; }
            { const Params p = load_params(); SchedGlu S{p, layer, G, c}; EpiGlu E{p, layer}; pg8::gemm_phase(lds, 512, S, E); }
            GSYNC();
            if (DBG_STOP == 4) { const Params p = load_params(); float a_ = 0.f; dbg_sum(p.pc(1), (size_t)TS * 512, a_); dbg_finish(p, a_); return; }
            { const Params p = load_params(); SchedMerge S{p, layer, G, c}; EpiMerge E{p.gates_(), p.hs(slab)}; pg8::gemm_phase(lds, 512, S, E); }
            if (TIME_REP == 3 && layer == 0 && slab == 0) { GSYNC(); const Params p = load_params(); SchedMerge S{p, layer, G, c}; EpiMerge E{p.gates_(), p.hs(slab)}; pg8::gemm_phase(lds, 512, S, E); }
            GSYNC();
            if (DBG_STOP == 5) { const Params p = load_params(); float a_ = 0.f; dbg_sum(p.h_(), (size_t)TS * 1024, a_); dbg_finish(p, a_); return; }
            { const Params p = load_params(); const float* xin = (layer == 0 ? p.x : p.out) + (size_t)slab * TS * DM; float* xout = p.out + (size_t)slab * TS * DM; SchedOut S{p, layer, G, c, p.hs(slab)}; EpiOut E{xin, xout}; pg8::gemm_phase(lds, 1024, S, E); }
            GSYNC();
        }
    }
#if TEST_TR == 1
    { const Params p = load_params(); const unsigned bad = *(volatile unsigned*)(p.wsb + O_CTR + 7168); const size_t gtid = (size_t)blockIdx.x * 512 + opaque_tid();
      if (bad > TEST_MAXBAD) p.out[gtid] = 1.0e4f; }
#endif
}

extern "C" void kernel_launch(void* const* d_in, const int* in_sizes, int n_in, void* d_out, int out_size, void* d_ws, size_t ws_size, hipStream_t stream) {
    constexpr size_t kDynLds = 147456;
    static int grid_blocks = 0;
    if (!grid_blocks) {
        int dev = 0, cus = 0, per_cu = 0;
        (void)hipGetDevice(&dev);
        (void)hipDeviceGetAttribute(&cus, hipDeviceAttributeMultiprocessorCount, dev);
        (void)hipFuncSetAttribute((const void*)fwd_megakernel, hipFuncAttributeMaxDynamicSharedMemorySize, (int)kDynLds);
        (void)hipOccupancyMaxActiveBlocksPerMultiprocessor(&per_cu, fwd_megakernel, 512, kDynLds);
        if (per_cu < 1) per_cu = 1;
        grid_blocks = cus * per_cu;
    }
    Params p{};
    const float** f = (const float**)&p;
    for (int i = 0; i < 28; ++i) f[i] = (const float*)d_in[i];
    p.out = (float*)d_out;
    p.wsb = (char*)d_ws; const size_t off = O_END + (size_t)TS * DM * 2;
    if (off > ws_size) { fprintf(stderr, "workspace too small: need %zu have %zu\n", off, ws_size); return; }
    (void)hipMemsetAsync(p.wsb + O_CTR, 0, 8192, stream);
    void* args[] = {&p};
    hipError_t e = hipLaunchCooperativeKernel((void*)fwd_megakernel, dim3(grid_blocks), dim3(512), args, kDynLds, stream);
    if (e != hipSuccess) fprintf(stderr, "cooperative launch failed: %s (grid %d)\n", hipGetErrorString(e), grid_blocks);
}
```

```cpp
#include <hip/hip_runtime.h>
#include <hip/hip_cooperative_groups.h>
#include <cstdio>
namespace cg = cooperative_groups;
#define LAS __attribute__((address_space(3)))
#define DI __device__ __forceinline__
typedef unsigned short bf16_t;
typedef short bf16x8 __attribute__((ext_vector_type(8)));
typedef short s16x4 __attribute__((ext_vector_type(4)));
typedef float f32x4 __attribute__((ext_vector_type(4)));
typedef float f32x16 __attribute__((ext_vector_type(16)));
typedef unsigned u32x4 __attribute__((ext_vector_type(4)));
typedef unsigned u32x2 __attribute__((ext_vector_type(2)));

constexpr int DM = 1024, NBATCH = 8, SEQ = 8192, DEPTH = 2, BW = 512, INC = 10240, MEML = 256;
constexpr int SLABB = 4, TS = SLABB * SEQ  , NSLAB = NBATCH / SLABB;
constexpr float EPSN = 1e-6f;

DI float bf2f(bf16_t b) { return __uint_as_float(((unsigned)b) << 16); }
DI bf16_t f2bf(float f) { unsigned u = __float_as_uint(f); u += 0x7FFFu + ((u >> 16) & 1u); return (bf16_t)(u >> 16); }
typedef __bf16 bf16n2 __attribute__((ext_vector_type(2)));
typedef float f32x2 __attribute__((ext_vector_type(2)));
DI unsigned pk2(float lo, float hi) { const f32x2 v = {lo, hi}; return __builtin_bit_cast(unsigned, __builtin_convertvector(v, bf16n2)); }
DI float lo2f(unsigned w) { return __uint_as_float(w << 16); }
DI float hi2f(unsigned w) { return __uint_as_float(w & 0xffff0000u); }
DI float sigmoidf_(float v) { return __builtin_amdgcn_rcpf(1.0f + __expf(-v)); }
DI float siluf_(float v) { return v * sigmoidf_(v); }
constexpr int WID_TABLE_OFF = 147456 - 16 - 256;
DI int hw_slot() { unsigned v; asm volatile("s_getreg_b32 %0, hwreg(HW_REG_HW_ID)" : "=s"(v)); return (int)((v & 15u) | (((v >> 4) & 3u) << 4)); }
DI int opaque_tid() { const int slot = hw_slot(); const int wid = __builtin_amdgcn_readfirstlane(*(const LAS int*)(size_t)(WID_TABLE_OFF + slot * 4));
    int lane; asm volatile("v_mbcnt_lo_u32_b32 %0, -1, 0\n\tv_mbcnt_hi_u32_b32 %0, -1, %0" : "=v"(lane)); return (wid << 6) | lane; }
DI void init_wid_table() { const int slot = hw_slot(); if ((threadIdx.x & 63) == 0) *(LAS int*)(size_t)(WID_TABLE_OFF + slot * 4) = (int)(threadIdx.x >> 6); __syncthreads(); }
DI int opaque_lane() { int lane; asm volatile("v_mbcnt_lo_u32_b32 %0, -1, 0\n\tv_mbcnt_hi_u32_b32 %0, -1, %0" : "=v"(lane)); return lane; }
DI float shx(float v, int m) { return __int_as_float(__builtin_amdgcn_ds_bpermute((opaque_lane() ^ m) << 2, __float_as_int(v))); }
DI unsigned shl_u(unsigned v, int src) { return (unsigned)__builtin_amdgcn_ds_bpermute(src << 2, (int)v); }
DI float wave_sum(float v) { for (int o = 32; o > 0; o >>= 1) v += shx(v, o); return v; }
DI float wave_max(float v) { for (int o = 32; o > 0; o >>= 1) v = fmaxf(v, shx(v, o)); return v; }

namespace pg8 {
constexpr int BM = 256, BK = 64, HALF = 128, HTB = HALF * BK * 2, STAGE_BYTES = 8 * HTB, NXCD = 8, WGM = 8;
__host__ __device__ __forceinline__ int lds_byte(int r, int c) { const int st = (r >> 4) * 2 + (c >> 5), rr = r & 15, cc = c & 31, ob = rr * 64 + cc * 2; return st * 1024 + (ob ^ (((ob >> 9) & 1) << 5)); }
__host__ __device__ __forceinline__ void stage_rc(int b, int& R, int& C) { const int st = b / 1024, sb = b % 1024, swz = sb ^ (((sb >> 9) & 1) << 5); R = (st >> 1) * 16 + swz / 64; C = (st & 1) * 32 + (swz % 64) / 2; }
__host__ __device__ __forceinline__ int perm32(int rho) { const int n = rho >> 4, i = rho & 15; return 8 * (i >> 2) + 4 * n + (i & 3); }

struct Unit { const char* A; const char* B; int row0, col0, aux; };

DI void tile_of(int L, int nM, int nN, int& pm, int& pn) {
    const int nwg = nM * nN; int wgid = L; { const int q = nwg / NXCD, r = nwg % NXCD, xcd = wgid % NXCD, off = wgid / NXCD; wgid = (xcd < r ? xcd * (q + 1) : r * (q + 1) + (xcd - r) * q) + off; }
    const int nig = WGM * nN, gid = wgid / nig, fm = gid * WGM, gsz = (nM - fm) < WGM ? (nM - fm) : WGM;
    pm = fm + ((wgid % nig) % gsz); pn = (wgid % nig) / gsz;
}

template <class Epi, class Sched>
DI void gemm_phase(LAS unsigned char* lds, const int K, const Sched& S, const Epi& E) {
    const int tid = opaque_tid(), wid = __builtin_amdgcn_readfirstlane(tid >> 6), lane = tid & 63, wr = wid >> 2, wc = wid & 3, fr = lane & 15, fq = lane >> 4;
    const int nt = K / BK;
    unsigned voffA[2], voffB[2];
#pragma unroll
    for (int i = 0; i < 2; ++i) { int R, C; stage_rc(tid * 16 + i * 8192, R, C); const int Rb = Epi::PERM ? ((R & ~31) + perm32(R & 31)) : R;
        voffA[i] = (unsigned)(R * K + C) * 2u; voffB[i] = (unsigned)(Rb * K + C) * 2u; }
    const size_t kstep = (size_t)(BK * 2);
    const size_t hstep = (size_t)HALF * K * 2;
    const unsigned ldsw = (unsigned)wid * 1024u;
    const int aoff = lds_byte(wr * 64 + fr, fq * 8), boff = lds_byte(wc * 32 + fr, fq * 8);
#define PG8_SA(b, h) (((b) * 2 + (h)) * HTB)
#define PG8_SB(b, h) ((4 + (b) * 2 + (h)) * HTB)
#define PG8_STAGE(bufoff, gbase, voff) do { _Pragma("unroll") for (int _i = 0; _i < 2; ++_i) \
        __builtin_amdgcn_global_load_lds((const unsigned*)((const char*)(gbase) + (voff)[_i]), (LAS unsigned*)(lds + (bufoff) + ldsw + _i * 8192), 16, 0, 0); } while (0)
#define PG8_LDA(dst, b, h) do { _Pragma("unroll") for (int m = 0; m < 4; ++m) _Pragma("unroll") for (int k = 0; k < 2; ++k) dst[m][k] = *(const LAS bf16x8*)(lds + PG8_SA(b, h) + aoff + m * 2048 + k * 1024); } while (0)
#define PG8_LDB(dst, b, h) do { _Pragma("unroll") for (int n = 0; n < 2; ++n) _Pragma("unroll") for (int k = 0; k < 2; ++k) dst[n][k] = *(const LAS bf16x8*)(lds + PG8_SB(b, h) + boff + n * 2048 + k * 1024); } while (0)
#define PG8_MMA(ai, bj, At, Bt) do { __builtin_amdgcn_s_setprio(1); _Pragma("unroll") for (int m = 0; m < 4; ++m) _Pragma("unroll") for (int n = 0; n < 2; ++n) _Pragma("unroll") for (int k = 0; k < 2; ++k) \
        acc[ai][bj][m][n] = __builtin_amdgcn_mfma_f32_16x16x32_bf16(Bt[n][k], At[m][k], acc[ai][bj][m][n], 0, 0, 0); __builtin_amdgcn_s_setprio(0); } while (0)
#define PG8_WAIT_V(n) asm volatile("s_waitcnt vmcnt(" #n ")" ::: "memory")
#define PG8_WAIT_L(n) asm volatile("s_waitcnt lgkmcnt(" #n ")" ::: "memory")
#define PG8_BAR __builtin_amdgcn_s_barrier()
#define PG8_SCHED __builtin_amdgcn_sched_barrier(0)
    Unit cur, nxt; int ui = 0;
    if (!S.next(0, cur)) return;
    f32x4 acc[2][2][4][2];
#pragma unroll
    for (int a = 0; a < 2; ++a)
#pragma unroll
        for (int b = 0; b < 2; ++b)
#pragma unroll
            for (int m = 0; m < 4; ++m)
#pragma unroll
                for (int n = 0; n < 2; ++n) acc[a][b][m][n] = (f32x4){0.f, 0.f, 0.f, 0.f};
    bf16x8 At[4][2], B0[2][2], B1[2][2];
    const char* cA = cur.A; const char* cB = cur.B;
    PG8_STAGE(PG8_SB(0, 0), cB, voffB); PG8_STAGE(PG8_SA(0, 0), cA, voffA); PG8_STAGE(PG8_SB(0, 1), cB + hstep, voffB); PG8_STAGE(PG8_SA(0, 1), cA + hstep, voffA);
    if (wr == 1) PG8_BAR;
    PG8_WAIT_V(4); PG8_BAR;
    PG8_STAGE(PG8_SB(1, 0), cB + kstep, voffB); PG8_STAGE(PG8_SA(1, 0), cA + kstep, voffA); PG8_STAGE(PG8_SB(1, 1), cB + hstep + kstep, voffB);
    PG8_WAIT_V(6); PG8_BAR;
    for (;;) {
        const bool has_next = S.next(ui + 1, nxt);
        const char* nA = has_next ? nxt.A : cA; const char* nB = has_next ? nxt.B : cB;
        for (int t = 0; t < nt; t += 2) {
            const bool last = (t == nt - 2);
            const char* a1 = cA + (size_t)(t + 1) * kstep;
            const char* a2 = last ? nA : cA + (size_t)(t + 2) * kstep; const char* b2 = last ? nB : cB + (size_t)(t + 2) * kstep;
            const char* a3 = a2 + kstep; const char* b3 = b2 + kstep;
            PG8_LDB(B0, 0, 0); PG8_SCHED; PG8_LDA(At, 0, 0); PG8_STAGE(PG8_SA(1, 1), a1 + hstep, voffA);
            PG8_WAIT_L(8); PG8_BAR; PG8_WAIT_L(0); PG8_MMA(0, 0, At, B0); PG8_BAR; PG8_SCHED;
            PG8_LDB(B1, 0, 1); PG8_STAGE(PG8_SB(0, 0), b2, voffB);
            PG8_BAR; PG8_WAIT_L(0); PG8_MMA(0, 1, At, B1); PG8_BAR;
            PG8_LDA(At, 0, 1); PG8_STAGE(PG8_SA(0, 0), a2, voffA);
            PG8_BAR; PG8_WAIT_L(0); PG8_MMA(1, 0, At, B0); PG8_BAR; PG8_SCHED;
            PG8_STAGE(PG8_SB(0, 1), b2 + hstep, voffB);
            PG8_WAIT_V(6); PG8_BAR; PG8_MMA(1, 1, At, B1); PG8_BAR;
            PG8_LDB(B0, 1, 0); PG8_SCHED; PG8_LDA(At, 1, 0); PG8_STAGE(PG8_SA(0, 1), a2 + hstep, voffA);
            PG8_WAIT_L(8); PG8_BAR; PG8_WAIT_L(0); PG8_MMA(0, 0, At, B0); PG8_BAR; PG8_SCHED;
            PG8_LDB(B1, 1, 1); PG8_STAGE(PG8_SB(1, 0), b3, voffB);
            PG8_BAR; PG8_WAIT_L(0); PG8_MMA(0, 1, At, B1); PG8_BAR;
            PG8_LDA(At, 1, 1); PG8_STAGE(PG8_SA(1, 0), a3, voffA);
            PG8_BAR; PG8_WAIT_L(0); PG8_MMA(1, 0, At, B0); PG8_BAR; PG8_SCHED;
            PG8_STAGE(PG8_SB(1, 1), b3 + hstep, voffB);
            PG8_WAIT_V(6); PG8_BAR; PG8_MMA(1, 1, At, B1); PG8_BAR;
        }
        const bool zero = E(acc, cur, wr, wc, fr, fq);
        if (!has_next) break;
        if (zero) {
#pragma unroll
        for (int a = 0; a < 2; ++a)
#pragma unroll
            for (int b = 0; b < 2; ++b)
#pragma unroll
                for (int m = 0; m < 4; ++m)
#pragma unroll
                    for (int n = 0; n < 2; ++n) acc[a][b][m][n] = (f32x4){0.f, 0.f, 0.f, 0.f};
        }
        cur = nxt; cA = nA; cB = nB; ++ui;
    }
    PG8_WAIT_V(0);
    if (wr == 0) PG8_BAR;
    PG8_BAR;
#undef PG8_SA
#undef PG8_SB
#undef PG8_STAGE
#undef PG8_LDA
#undef PG8_LDB
#undef PG8_MMA
#undef PG8_WAIT_V
#undef PG8_WAIT_L
#undef PG8_BAR
#undef PG8_SCHED
}
}
using pg8::Unit;
constexpr size_t al256(size_t v) { return (v + 255) & ~(size_t)255; }
constexpr size_t O_CTR = 0, O_WTIN = 8192, O_WTGLU = O_WTIN + al256((size_t)DEPTH * INC * DM * 2), O_WTBR = O_WTGLU + al256((size_t)DEPTH * 512 * 512 * 2), O_WTOUT = O_WTBR + al256((size_t)DEPTH * 4 * 1024 * 512 * 2),
    O_WTKV = O_WTOUT + al256((size_t)DEPTH * DM * DM * 2), O_MEMH = O_WTKV + al256((size_t)DEPTH * DM * DM * 2), O_MK = O_MEMH + al256((size_t)2048 * DM * 2), O_MVT = O_MK + al256((size_t)DEPTH * 2048 * 512 * 2),
    O_DCOS = O_MVT + al256((size_t)DEPTH * 512 * 2048 * 2), O_DSIN = O_DCOS + al256((size_t)SEQ * 32 * 4), O_RCOS = O_DSIN + al256((size_t)SEQ * 32 * 4), O_RSIN = O_RCOS + al256((size_t)SEQ * 64 * 4),
    O_RCOST = O_RSIN + al256((size_t)SEQ * 64 * 4), O_RSINT = O_RCOST + al256((size_t)SEQ * 64 * 4), O_ABAR = O_RSINT + al256((size_t)SEQ * 64 * 4), O_BBAR = O_ABAR + al256((size_t)DEPTH * 32 * 64 * 2 * 4),
    O_CCT = O_BBAR + al256((size_t)DEPTH * 32 * 128 * 16 * 2), O_H = O_CCT + al256((size_t)DEPTH * 32 * 16 * 128 * 2), O_ZBUF = O_H + al256((size_t)TS * DM * 2), O_GATES = O_ZBUF + al256((size_t)TS * 512 * 2),
    O_PCB = O_GATES + al256((size_t)4 * TS * 1024 * 2), O_END = O_PCB + al256((size_t)16 * TS * 512 * 2);
struct WsView {
    char* b;
    DI unsigned* ctr() const { return (unsigned*)(b + O_CTR); }
    DI bf16_t* at(size_t o) const { return (bf16_t*)(b + o); }
    DI float* fat(size_t o) const { return (float*)(b + o); }
};
struct Params {
    const float *x, *mem, *norm_g, *w_in, *lam_re, *lam_im, *log_dt, *b_re, *b_im, *c_re, *c_im, *ssm_d, *w_glu, *b_glu;
    const float *dq_g, *dk_g, *lq1, *lk1, *lq2, *lk2, *hn_g, *mem_norm_g, *w_mem_kv, *mq_g, *mk_g, *w_branch, *b_merge, *w_out;
    float* out;
    char* wsb;
    DI const float* scal() const { char* b_ = wsb; asm volatile("" : "+s"(b_)); return (const float*)(__attribute__((address_space(1))) char*)(b_ + O_CTR + 4096); }
#define WSF(name, T, OFF) DI T* name##_() const { char* b_ = wsb; asm volatile("" : "+s"(b_)); return (T*)(__attribute__((address_space(1))) char*)(b_ + (OFF)); }
    WSF(ctr, unsigned, O_CTR) WSF(wt_in, bf16_t, O_WTIN) WSF(wt_glu, bf16_t, O_WTGLU) WSF(wt_br, bf16_t, O_WTBR) WSF(wt_out, bf16_t, O_WTOUT) WSF(wt_kv, bf16_t, O_WTKV) WSF(memh, bf16_t, O_MEMH)
    WSF(mk, bf16_t, O_MK) WSF(mvt, bf16_t, O_MVT) WSF(dcos, float, O_DCOS) WSF(dsin, float, O_DSIN) WSF(rcos, float, O_RCOS) WSF(rsin, float, O_RSIN) WSF(rcosT, float, O_RCOST) WSF(rsinT, float, O_RSINT)
    WSF(abar, float, O_ABAR) WSF(bbar, bf16_t, O_BBAR) WSF(cct, bf16_t, O_CCT) WSF(h, bf16_t, O_H) WSF(zbuf, bf16_t, O_ZBUF) WSF(gates, bf16_t, O_GATES) WSF(pcb, bf16_t, O_PCB)
#undef WSF
    DI bf16_t* pc(int i) const { return pcb_() + (size_t)i * TS * 512; }
    DI bf16_t* pt(int i) const { return pcb_() + (size_t)(i == 0 ? 12 : (i == 1 ? 4 : 8)) * TS * 512; }
};

#define FOR_ACC_PERM(...) \
    _Pragma("unroll") for (int ai = 0; ai < 2; ++ai) _Pragma("unroll") for (int m = 0; m < 4; ++m) { const int row = u.row0 + ai * 128 + wr * 64 + m * 16 + fr; \
    _Pragma("unroll") for (int bj = 0; bj < 2; ++bj) { const int col = u.col0 + bj * 128 + wc * 32 + 8 * fq; f32x4& v0 = acc[ai][bj][m][0]; f32x4& v1 = acc[ai][bj][m][1]; __VA_ARGS__ asm volatile("" ::: "memory"); } }

DI u32x4 pack8(const f32x4& v0, const f32x4& v1) { u32x4 w; w.x = pk2(v0[0], v0[1]); w.y = pk2(v0[2], v0[3]); w.z = pk2(v1[0], v1[1]); w.w = pk2(v1[2], v1[3]); return w; }
DI void unpack8(const u32x4 w, float (&f)[8]) { f[0] = lo2f(w.x); f[1] = hi2f(w.x); f[2] = lo2f(w.y); f[3] = hi2f(w.y); f[4] = lo2f(w.z); f[5] = hi2f(w.z); f[6] = lo2f(w.w); f[7] = hi2f(w.w); }

struct EpiIn {
    static constexpr bool PERM = true;
    Params p; int layer;
    DI bool operator()(f32x4 (&acc)[2][2][4][2], const Unit& u, int wr, int wc, int fr, int fq) const {
        const int v = u.aux;
        if (v >= 36) {
            const int sv = v - 36;
            if (sv < 2) {
                bf16_t* dst = p.pt(0); const int hd = (u.row0 >> 7) + wr; const float lg2 = log2f(1.0f - exp2f(-5.0f - (float)hd));
#pragma unroll
                for (int m = 0; m < 4; ++m) { const int d1 = 16 * m + fr; const float* ct_ = p.rcosT_() + (size_t)d1 * SEQ; const float* st_ = p.rsinT_() + (size_t)d1 * SEQ;
                    const size_t r1 = (size_t)(u.row0 + 128 * wr + d1) * TS;
                    f32x4 tb_[2][4];
#pragma unroll
                    for (int bj = 0; bj < 2; ++bj) { const int pos = (u.col0 + bj * 128 + wc * 32 + 8 * fq) & (SEQ - 1);
                        tb_[bj][0] = *(const f32x4*)(ct_ + pos); tb_[bj][1] = *(const f32x4*)(ct_ + pos + 4); tb_[bj][2] = *(const f32x4*)(st_ + pos); tb_[bj][3] = *(const f32x4*)(st_ + pos + 4); }
#pragma unroll
                    for (int bj = 0; bj < 2; ++bj) { const int col = u.col0 + bj * 128 + wc * 32 + 8 * fq; const int pos = col & (SEQ - 1);
                        const f32x4 c0 = tb_[bj][0], c1 = tb_[bj][1], s0 = tb_[bj][2], s1 = tb_[bj][3];
                        const f32x4 a0 = acc[0][bj][m][0], a1 = acc[0][bj][m][1], b0 = acc[1][bj][m][0], b1 = acc[1][bj][m][1]; f32x4 o0, o1, q0, q1;
#pragma unroll
                        for (int j = 0; j < 4; ++j) { const float k0 = 0.08838834764831845f * exp2f(lg2 * (float)(63 - ((pos + j) & 63))), k1 = 0.08838834764831845f * exp2f(lg2 * (float)(63 - ((pos + 4 + j) & 63)));
                            o0[j] = (a0[j] * c0[j] - b0[j] * s0[j]) * k0; q0[j] = (b0[j] * c0[j] + a0[j] * s0[j]) * k0; o1[j] = (a1[j] * c1[j] - b1[j] * s1[j]) * k1; q1[j] = (b1[j] * c1[j] + a1[j] * s1[j]) * k1; }
                        *(u32x4*)(dst + r1 + col) = pack8(o0, o1); *(u32x4*)(dst + r1 + (size_t)64 * TS + col) = pack8(q0, q1); asm volatile("" ::: "memory"); } }
            } else {
                bf16_t* dst = p.pt(sv >> 1);
                FOR_ACC_PERM({ *(u32x4*)(dst + (size_t)row * TS + col) = pack8(v0, v1); })
            }
        } else {
            const int ct = v < 8 ? v : (v < 14 ? v + 2 : v + 4);
            if (ct >= 4 && ct < 8) {
                bf16_t* dst = p.pc(ct >> 1) + u.col0 + 128 * (wc >> 1) + 32 * (wc & 1) + 8 * fq; const float sc = (ct >= 6) ? 0.08838834764831845f : 1.0f; const int f0 = 32 * (wc & 1) + 8 * fq;
                const float* rc_ = p.rcos_(); const float* rs_ = p.rsin_();
#pragma unroll
                for (int ai = 0; ai < 2; ++ai)
#pragma unroll
                  for (int mh = 0; mh < 2; ++mh) { f32x4 tb_[4][4];
#pragma unroll
                    for (int m = 2 * mh; m < 2 * mh + 2; ++m) { const int pos = (u.row0 + ai * 128 + wr * 64 + m * 16 + fr) & (SEQ - 1); const float* cp = rc_ + (size_t)pos * 64 + f0; const float* sp = rs_ + (size_t)pos * 64 + f0;
                        tb_[m][0] = *(const f32x4*)cp; tb_[m][1] = *(const f32x4*)(cp + 4); tb_[m][2] = *(const f32x4*)sp; tb_[m][3] = *(const f32x4*)(sp + 4); }
#pragma unroll
                    for (int m = 2 * mh; m < 2 * mh + 2; ++m) { const int row = u.row0 + ai * 128 + wr * 64 + m * 16 + fr;
                        const f32x4 c0 = tb_[m][0], c1 = tb_[m][1], s0 = tb_[m][2], s1 = tb_[m][3];
                        const f32x4 a0 = acc[ai][0][m][0], a1 = acc[ai][0][m][1], b0 = acc[ai][1][m][0], b1 = acc[ai][1][m][1]; f32x4 o0, o1, q0, q1;
#pragma unroll
                        for (int j = 0; j < 4; ++j) { o0[j] = (a0[j] * c0[j] - b0[j] * s0[j]) * sc; q0[j] = (b0[j] * c0[j] + a0[j] * s0[j]) * sc; o1[j] = (a1[j] * c1[j] - b1[j] * s1[j]) * sc; q1[j] = (b1[j] * c1[j] + a1[j] * s1[j]) * sc; }
                        *(u32x4*)(dst + (size_t)row * 512) = pack8(o0, o1); *(u32x4*)(dst + (size_t)row * 512 + 64) = pack8(q0, q1); } }
            } else if (ct >= 12 && ct < 16) {
                const bool isq = ct < 14; bf16_t* dst = p.pc(ct >> 1) + u.col0 + 64 * wc + 8 * fq; const float* gn = (isq ? p.dq_g : p.dk_g) + layer * 64 + 8 * fq;
                const f32x4 g0 = *(const f32x4*)gn, g1 = *(const f32x4*)(gn + 4), h0 = *(const f32x4*)(gn + 32), h1 = *(const f32x4*)(gn + 36);
                const float* dc_ = p.dcos_(); const float* ds_ = p.dsin_();
#pragma unroll
                for (int ai = 0; ai < 2; ++ai)
#pragma unroll
                  for (int mh = 0; mh < 2; ++mh) { f32x4 tb_[4][4];
#pragma unroll
                    for (int m = 2 * mh; m < 2 * mh + 2; ++m) { const int pos = (u.row0 + ai * 128 + wr * 64 + m * 16 + fr) & (SEQ - 1); const float* cp = dc_ + (size_t)pos * 32 + 8 * fq; const float* sp = ds_ + (size_t)pos * 32 + 8 * fq;
                        tb_[m][0] = *(const f32x4*)cp; tb_[m][1] = *(const f32x4*)(cp + 4); tb_[m][2] = *(const f32x4*)sp; tb_[m][3] = *(const f32x4*)(sp + 4); }
#pragma unroll
                    for (int m = 2 * mh; m < 2 * mh + 2; ++m) { const int row = u.row0 + ai * 128 + wr * 64 + m * 16 + fr;
                        const f32x4 a0 = acc[ai][0][m][0], a1 = acc[ai][0][m][1], b0 = acc[ai][1][m][0], b1 = acc[ai][1][m][1];
                        float ss = 0.f;
#pragma unroll
                        for (int j = 0; j < 4; ++j) ss += a0[j] * a0[j] + a1[j] * a1[j] + b0[j] * b0[j] + b1[j] * b1[j];
                        ss += shx(ss, 16); ss += shx(ss, 32); const float rs = rsqrtf(ss * (1.0f / 64.0f) + EPSN) * (isq ? 0.125f : 1.0f);
                        const f32x4 c0 = tb_[m][0], c1 = tb_[m][1], s0 = tb_[m][2], s1 = tb_[m][3]; f32x4 o0, o1, q0, q1;
#pragma unroll
                        for (int j = 0; j < 4; ++j) { const float x0 = a0[j] * rs * g0[j], y0 = b0[j] * rs * h0[j], x1 = a1[j] * rs * g1[j], y1 = b1[j] * rs * h1[j];
                            o0[j] = x0 * c0[j] - y0 * s0[j]; q0[j] = y0 * c0[j] + x0 * s0[j]; o1[j] = x1 * c1[j] - y1 * s1[j]; q1[j] = y1 * c1[j] + x1 * s1[j]; }
                        *(u32x4*)(dst + (size_t)row * 512) = pack8(o0, o1); *(u32x4*)(dst + (size_t)row * 512 + 32) = pack8(q0, q1); } }
            } else if (ct < 24) { bf16_t* dst = p.pc(ct >> 1);
                FOR_ACC_PERM({ *(u32x4*)(dst + (size_t)row * 512 + col) = pack8(v0, v1); })
            } else {
                const int d0 = u.col0 + 16 * wc + 4 * fq; const float* bm = p.b_merge + (size_t)layer * 4096 + d0;
                const f32x4 b0 = *(const f32x4*)(bm), b1 = *(const f32x4*)(bm + 1024), b2 = *(const f32x4*)(bm + 2048), b3 = *(const f32x4*)(bm + 3072);
                bf16_t* gp = p.gates_() + d0;
#pragma unroll
                for (int ai = 0; ai < 2; ++ai)
#pragma unroll
                    for (int m = 0; m < 4; ++m) { const size_t ro = (size_t)(u.row0 + ai * 128 + wr * 64 + m * 16 + fr) * 1024; f32x4 g0, g1, g2, g3;
#pragma unroll
                        for (int j = 0; j < 4; ++j) { g0[j] = sigmoidf_(fminf(fmaxf(acc[ai][0][m][0][j] + b0[j], -30.f), 30.f)); g1[j] = sigmoidf_(fminf(fmaxf(acc[ai][0][m][1][j] + b1[j], -30.f), 30.f));
                            g2[j] = sigmoidf_(fminf(fmaxf(acc[ai][1][m][0][j] + b2[j], -30.f), 30.f)); g3[j] = sigmoidf_(fminf(fmaxf(acc[ai][1][m][1][j] + b3[j], -30.f), 30.f)); }
                        u32x2 w0, w1, w2, w3;
                        f32x4 r1, r2, r3;
#pragma unroll
                        for (int j = 0; j < 4; ++j) { r1[j] = __builtin_amdgcn_rcpf(g1[j]); r2[j] = __builtin_amdgcn_rcpf(g2[j]); r3[j] = __builtin_amdgcn_rcpf(g3[j]); }
                        w0.x = pk2(g0[0] * r1[0], g0[1] * r1[1]); w0.y = pk2(g0[2] * r1[2], g0[3] * r1[3]); w1.x = pk2(g1[0] * r2[0], g1[1] * r2[1]); w1.y = pk2(g1[2] * r2[2], g1[3] * r2[3]);
                        w2.x = pk2(g2[0] * r3[0], g2[1] * r3[1]); w2.y = pk2(g2[2] * r3[2], g2[3] * r3[3]); w3.x = pk2(g3[0], g3[1]); w3.y = pk2(g3[2], g3[3]);
                        *(u32x2*)(gp + ro) = w0; *(u32x2*)(gp + (size_t)TS * 1024 + ro) = w1; *(u32x2*)(gp + (size_t)2 * TS * 1024 + ro) = w2; *(u32x2*)(gp + (size_t)3 * TS * 1024 + ro) = w3; }
            }
        }
        return true;
    }
};
struct SchedIn {
    Params p; int layer, G, c;
    DI bool next(int i, Unit& u) const {
        const int L = i * G + c; if (L >= (TS / 256) * 42) return false;
        int pm, pn; pg8::tile_of(L, TS / 256, 42, pm, pn);
        const char* W = (const char*)(p.wt_in_() + (size_t)layer * INC * DM); const char* H = (const char*)p.h_();
        u.aux = pn;
        if (pn < 36) { const int ct = pn < 8 ? pn : (pn < 14 ? pn + 2 : pn + 4);
            u.A = H + (size_t)pm * 256 * DM * 2; u.B = W + (size_t)ct * 256 * DM * 2; u.row0 = pm * 256; u.col0 = ct < 24 ? (ct & 1) * 256 : (ct - 24) * 64;
        } else { const int sv = pn - 36; const int piece = sv < 2 ? 3 : (sv < 4 ? 4 : 8);
            u.A = W + (size_t)(piece * 512 + (sv & 1) * 256) * DM * 2; u.B = H + (size_t)pm * 256 * DM * 2; u.row0 = (sv & 1) * 256; u.col0 = pm * 256; }
        return true;
    }
};
struct EpiKV {
    static constexpr bool PERM = true;
    Params p;
    DI bool operator()(f32x4 (&acc)[2][2][4][2], const Unit& u, int wr, int wc, int fr, int fq) const {
        const int layer = u.aux >> 1, sw = u.aux & 1;
        if (sw) { bf16_t* dst = p.mvt_() + (size_t)layer * 512 * 2048; FOR_ACC_PERM({ *(u32x4*)(dst + (size_t)row * 2048 + col) = pack8(v0, v1); }) }
        else { bf16_t* dst = p.mk_() + (size_t)layer * 2048 * 512; FOR_ACC_PERM({ *(u32x4*)(dst + (size_t)row * 512 + col) = pack8(v0, v1); }) }
        return true;
    }
};
struct SchedKV {
    Params p; int G, c;
    DI bool next(int i, Unit& u) const {
        const int L = i * G + c; if (L >= 8 * 8) return false;
        const int pm = L & 7, q = L >> 3, layer = q >> 2, t = q & 3;
        const char* W = (const char*)(p.wt_kv_() + (size_t)layer * 1024 * 1024); const char* H = (const char*)p.memh_();
        if (t < 2) { u.A = H + (size_t)pm * 256 * DM * 2; u.B = W + (size_t)t * 256 * DM * 2; u.row0 = pm * 256; u.col0 = t * 256; u.aux = layer * 2; }
        else { u.A = W + (size_t)(512 + (t - 2) * 256) * DM * 2; u.B = H + (size_t)pm * 256 * DM * 2; u.row0 = (t - 2) * 256; u.col0 = pm * 256; u.aux = layer * 2 + 1; }
        return true;
    }
};
struct EpiGlu {
    static constexpr bool PERM = true;
    Params p; int layer;
    DI bool operator()(f32x4 (&acc)[2][2][4][2], const Unit& u, int wr, int wc, int fr, int fq) const {
        const float* bg = p.b_glu + (size_t)layer * 512; const int colb = u.col0 + wc * 32 + 8 * fq;
        f32x4 bb[2][2];
#pragma unroll
        for (int bj = 0; bj < 2; ++bj) { bb[bj][0] = *(const f32x4*)(bg + colb + bj * 128); bb[bj][1] = *(const f32x4*)(bg + colb + bj * 128 + 4); }
        const bf16_t* zp = p.zbuf_(); bf16_t* gp = p.pc(1);
#pragma unroll
        for (int ai = 0; ai < 2; ++ai) {
            u32x4 zv[4][2], gv[4][2];
#pragma unroll
            for (int m = 0; m < 4; ++m)
#pragma unroll
                for (int bj = 0; bj < 2; ++bj) { const size_t o = (size_t)(u.row0 + ai * 128 + wr * 64 + m * 16 + fr) * 512 + colb + bj * 128; zv[m][bj] = *(const u32x4*)(zp + o); gv[m][bj] = *(const u32x4*)(gp + o); }
#pragma unroll
            for (int m = 0; m < 4; ++m)
#pragma unroll
                for (int bj = 0; bj < 2; ++bj) { const size_t o = (size_t)(u.row0 + ai * 128 + wr * 64 + m * 16 + fr) * 512 + colb + bj * 128; float z[8], g[8]; unpack8(zv[m][bj], z); unpack8(gv[m][bj], g);
                    const f32x4& v0 = acc[ai][bj][m][0]; const f32x4& v1 = acc[ai][bj][m][1]; f32x4 o0, o1;
#pragma unroll
                    for (int j = 0; j < 4; ++j) { o0[j] = z[j] * sigmoidf_(v0[j] + bb[bj][0][j]) * siluf_(g[j]); o1[j] = z[4 + j] * sigmoidf_(v1[j] + bb[bj][1][j]) * siluf_(g[4 + j]); }
                    *(u32x4*)(gp + o) = pack8(o0, o1); }
        }
        return true;
    }
};
struct SchedGlu {
    Params p; int layer, G, c;
    DI bool next(int i, Unit& u) const {
        const int L = i * G + c; if (L >= (TS / 256) * 2) return false;
        const int pm = L >> 1, pn = L & 1;
        u.A = (const char*)(p.zbuf_() + (size_t)pm * 256 * 512); u.B = (const char*)(p.wt_glu_() + (size_t)layer * 512 * 512 + (size_t)pn * 256 * 512); u.row0 = pm * 256; u.col0 = pn * 256; u.aux = 0;
        return true;
    }
};
struct EpiMerge {
    static constexpr bool PERM = true;
    const bf16_t* gates; bf16_t* merged;
    DI bool operator()(f32x4 (&acc)[2][2][4][2], const Unit& u, int wr, int wc, int fr, int fq) const {
        const int n = u.aux; const bool lastn = (n == 3); const bf16_t* g0p = gates + (size_t)n * TS * 1024; const int colb = u.col0 + wc * 32 + 8 * fq;
        u32x4 gv[2][4][2];
#pragma unroll
        for (int ai = 0; ai < 2; ++ai)
#pragma unroll
            for (int m = 0; m < 4; ++m)
#pragma unroll
                for (int bj = 0; bj < 2; ++bj) gv[ai][m][bj] = *(const u32x4*)(g0p + (size_t)(u.row0 + ai * 128 + wr * 64 + m * 16 + fr) * 1024 + colb + bj * 128);
#pragma unroll
        for (int ai = 0; ai < 2; ++ai)
#pragma unroll
            for (int m = 0; m < 4; ++m)
#pragma unroll
                for (int bj = 0; bj < 2; ++bj) { float a[8]; unpack8(gv[ai][m][bj], a); f32x4& v0 = acc[ai][bj][m][0]; f32x4& v1 = acc[ai][bj][m][1];
#pragma unroll
                    for (int j = 0; j < 4; ++j) { v0[j] *= a[j]; v1[j] *= a[4 + j]; }
                    if (lastn) { *(u32x4*)(merged + (size_t)(u.row0 + ai * 128 + wr * 64 + m * 16 + fr) * 1024 + colb + bj * 128) = pack8(v0, v1); v0 = (f32x4){0.f, 0.f, 0.f, 0.f}; v1 = (f32x4){0.f, 0.f, 0.f, 0.f}; } }
        return false;
    }
};
struct SchedMerge {
    Params p; int layer, G, c;
    DI bool next(int i, Unit& u) const {
        const int ti = i >> 2, n = i & 3; const int L = ti * G + c; if (L >= (TS / 256) * 4) return false;
        int pm, pn; pg8::tile_of(L, TS / 256, 4, pm, pn);
        const bf16_t* A = n == 0 ? p.pc(1) : p.pc(12 + n);
        u.A = (const char*)(A + (size_t)pm * 256 * 512); u.B = (const char*)(p.wt_br_() + ((size_t)(layer * 4 + n) * 1024 + (size_t)pn * 256) * 512); u.row0 = pm * 256; u.col0 = pn * 256; u.aux = n;
        return true;
    }
};
struct EpiOut {
    static constexpr bool PERM = false;
    const float* xin; float* xout;
    DI bool operator()(f32x4 (&acc)[2][2][4][2], const Unit& u, int wr, int wc, int fr, int fq) const {
#pragma unroll
        for (int ai = 0; ai < 2; ++ai) { f32x4 xv[4][2][2];
#pragma unroll
            for (int m = 0; m < 4; ++m)
#pragma unroll
                for (int bj = 0; bj < 2; ++bj)
#pragma unroll
                    for (int n = 0; n < 2; ++n) xv[m][bj][n] = *(const f32x4*)(xin + (size_t)(u.row0 + ai * 128 + wr * 64 + m * 16 + fr) * 1024 + u.col0 + wc * 32 + 4 * fq + bj * 128 + n * 16);
#pragma unroll
            for (int m = 0; m < 4; ++m)
#pragma unroll
                for (int bj = 0; bj < 2; ++bj)
#pragma unroll
                    for (int n = 0; n < 2; ++n) *(f32x4*)(xout + (size_t)(u.row0 + ai * 128 + wr * 64 + m * 16 + fr) * 1024 + u.col0 + wc * 32 + 4 * fq + bj * 128 + n * 16) = xv[m][bj][n] + acc[ai][bj][m][n];
        }
        return true;
    }
};
struct SchedOut {
    Params p; int layer, G, c;
    DI bool next(int i, Unit& u) const {
        const int L = i * G + c; if (L >= (TS / 256) * 4) return false;
        int pm, pn; pg8::tile_of(L, TS / 256, 4, pm, pn);
        u.A = (const char*)(p.h_() + (size_t)pm * 256 * 1024); u.B = (const char*)(p.wt_out_() + ((size_t)layer * 1024 + (size_t)pn * 256) * 1024); u.row0 = pm * 256; u.col0 = pn * 256; u.aux = 0;
        return true;
    }
};
DI int win_row(int cidx) {
    if (cidx < 6144) { const int piece = cidx >> 9, lc = cidx & 511, tile = lc >> 8, l = lc & 255;
        if (piece == 2 || piece == 3) { const int head = l >> 7, d = l & 127, bj = d >> 6, rem = d & 63; return (cidx & ~255) + 128 * bj + 32 * (2 * head + (rem >> 5)) + (rem & 31); }
        if (piece == 6 || piece == 7) { const int un = l >> 6, d = l & 63; return (cidx & ~255) + 128 * (d >> 5) + 32 * un + (d & 31); }
        (void)tile; return cidx; }
    const int n = (cidx - 6144) >> 10, d = (cidx - 6144) & 1023, tile = d >> 6, dd = d & 63;
    return 6144 + tile * 256 + 128 * (n >> 1) + 32 * (dd >> 4) + 8 * ((dd & 15) >> 2) + 4 * (n & 1) + (dd & 3); }
template <bool WIN>
DI void transpose_job(LAS float* tl, const float* src, bf16_t* dst, int R, int C, const float* scale, int& tctr) {
    const int ntr = R / 64, ntc = C / 64, nt = ntr * ntc, G = (int)gridDim.x; const int tid_ = opaque_tid(); const int tx = tid_ & 63, ty = tid_ >> 6;
    const int first = ((int)blockIdx.x - (tctr % G) + G) % G;
    tctr += nt;
    for (int t0 = first; t0 < nt; t0 += 4 * G) {
        __syncthreads();
#pragma unroll
        for (int k = 0; k < 4; ++k) { const int t = t0 + k * G; if (t < nt) { const int tr = t / ntc, tc = t - tr * ntc; LAS float* tk = tl + k * (64 * 65);
#pragma unroll
            for (int i = 0; i < 8; ++i) { const int r = ty + 8 * i; float v = src[(size_t)(tr * 64 + r) * C + tc * 64 + tx]; if (scale) v *= scale[tr * 64 + r]; tk[r * 65 + tx] = v; } } }
        __syncthreads();
#pragma unroll
        for (int k = 0; k < 4; ++k) { const int t = t0 + k * G; if (t < nt) { const int tr = t / ntc, tc = t - tr * ntc; const LAS float* tk = tl + k * (64 * 65);
#pragma unroll
            for (int i = 0; i < 8; ++i) { const int cc = ty + 8 * i; const int drow = WIN ? win_row(tc * 64 + cc) : tc * 64 + cc; dst[(size_t)drow * R + tr * 64 + tx] = f2bf(tk[tx * 65 + cc]); } } }
    }
}

DI void phase_prep(const Params& p, LAS unsigned char* lds) {
    LAS float* tl = (LAS float*)lds; int tctr = 0;
    for (int l = 0; l < DEPTH; ++l) {
        transpose_job<true>(tl, p.w_in + (size_t)l * DM * INC, p.wt_in_() + (size_t)l * INC * DM, DM, INC, p.norm_g + l * DM, tctr);
        transpose_job<false>(tl, p.w_glu + (size_t)l * 512 * 512, p.wt_glu_() + (size_t)l * 512 * 512, 512, 512, nullptr, tctr);
        for (int n = 0; n < 4; ++n) transpose_job<false>(tl, p.w_branch + (size_t)(l * 4 + n) * 512 * 1024, p.wt_br_() + (size_t)(l * 4 + n) * 1024 * 512, 512, 1024, nullptr, tctr);
        transpose_job<false>(tl, p.w_out + (size_t)l * DM * DM, p.wt_out_() + (size_t)l * DM * DM, DM, DM, nullptr, tctr);
        transpose_job<false>(tl, p.w_mem_kv + (size_t)l * DM * DM, p.wt_kv_() + (size_t)l * DM * DM, DM, DM, p.mem_norm_g + l * DM, tctr);
    }
    const long gtid = (long)blockIdx.x * 512 + opaque_tid(), gn = (long)gridDim.x * 512;
    for (long i = gtid; i < (long)SEQ * 32; i += gn) { const int pos = (int)(i >> 5), d = (int)(i & 31);
        const float inv = (float)exp(-(double)(2 * d) / 64.0 * 9.210340371976184); const float ang = (float)pos * inv; float s, c; sincosf(ang, &s, &c); p.dcos_()[i] = c; p.dsin_()[i] = s; }
    for (long i = gtid; i < (long)SEQ * 64; i += gn) { const int pos = (int)(i >> 6), d = (int)(i & 63);
        const float lin = (float)d / 63.0f; const float inv = 1.0f / (float)exp((double)lin * 9.210340371976184); const float ang = (float)pos * inv; float s, c; sincosf(ang, &s, &c);
        p.rcos_()[i] = c; p.rsin_()[i] = s; p.rcosT_()[(size_t)d * SEQ + pos] = c; p.rsinT_()[(size_t)d * SEQ + pos] = s; }
    for (long i = gtid; i < (long)DEPTH * 32 * 64; i += gn) { const int pp = (int)(i & 63), g = (int)((i >> 6) & 31), l = (int)(i >> 11);
        const float lr = fminf(p.lam_re[i], -1e-4f), li = p.lam_im[i], dt = expf(p.log_dt[l * 32 + g]);
        const float mag = expf(lr * dt); float sn, cs; sincosf(li * dt, &sn, &cs); const float are = mag * cs, aim = mag * sn;
        const float nr = are - 1.0f, ni = aim, den = lr * lr + li * li; const float fre = (nr * lr + ni * li) / den, fim = (ni * lr - nr * li) / den;
        p.abar_()[i * 2] = are; p.abar_()[i * 2 + 1] = aim;
        bf16_t* bb = p.bbar_() + ((size_t)(l * 32 + g) * 128) * 16; const float* br = p.b_re + i * 16; const float* bi = p.b_im + i * 16;
        for (int hch = 0; hch < 16; ++hch) { bb[(size_t)pp * 16 + hch] = f2bf(fre * br[hch] - fim * bi[hch]); bb[(size_t)(64 + pp) * 16 + hch] = f2bf(fre * bi[hch] + fim * br[hch]); }
        bf16_t* cc = p.cct_() + ((size_t)(l * 32 + g) * 16) * 128;
        for (int hch = 0; hch < 16; ++hch) { const size_t ci = ((size_t)(l * 32 + g) * 16 + hch) * 64 + pp; cc[hch * 128 + pp] = f2bf(p.c_re[ci]); cc[hch * 128 + 64 + pp] = f2bf(-p.c_im[ci]); }
    }
    if (blockIdx.x == 0 && threadIdx.x < 64) { const int lane = threadIdx.x; float* sc = (float*)(p.wsb + O_CTR + 4096);
        for (int l = 0; l < DEPTH; ++l) { const float lam_init = l == 0 ? 0.2f : 0.35550906759096926f;
            float s1 = p.lq1[l * 64 + lane] * p.lk1[l * 64 + lane], s2 = p.lq2[l * 64 + lane] * p.lk2[l * 64 + lane]; s1 = wave_sum(s1); s2 = wave_sum(s2);
            const float mdq = wave_max(fabsf(p.dq_g[l * 64 + lane])), mdk = wave_max(fabsf(p.dk_g[l * 64 + lane]));
            const float mmq = wave_max(fmaxf(fabsf(p.mq_g[l * 128 + lane]), fabsf(p.mq_g[l * 128 + 64 + lane]))), mmk = wave_max(fmaxf(fabsf(p.mk_g[l * 128 + lane]), fabsf(p.mk_g[l * 128 + 64 + lane])));
            if (lane == 0) { sc[l * 8] = expf(s1) - expf(s2) + lam_init; sc[l * 8 + 1] = -8.0f * mdq * mdk * 1.4426950408889634f; sc[l * 8 + 2] = -11.313708498984761f * mmq * mmk * 1.4426950408889634f; } } }
    { const int tid_ = opaque_tid(); const int wv = (blockIdx.x * 8 + (tid_ >> 6)), nwv = gridDim.x * 8, lane = tid_ & 63;
      for (int r = wv; r < NBATCH * MEML; r += nwv) { const float* s = p.mem + (size_t)r * DM; f32x4 v[4]; float ss = 0.f;
#pragma unroll
          for (int i = 0; i < 4; ++i) { v[i] = *(const f32x4*)(s + i * 256 + lane * 4); ss += v[i][0] * v[i][0] + v[i][1] * v[i][1] + v[i][2] * v[i][2] + v[i][3] * v[i][3]; }
          ss = wave_sum(ss); const float rs = rsqrtf(ss * (1.0f / DM) + EPSN);
#pragma unroll
          for (int i = 0; i < 4; ++i) { u32x2 w; w.x = pk2(v[i][0] * rs, v[i][1] * rs); w.y = pk2(v[i][2] * rs, v[i][3] * rs); *(u32x2*)(p.memh_() + (size_t)r * DM + i * 256 + lane * 4) = w; } } }
}

DI void phase_norm(const Params& p, const float* xs) {
    const int tid_ = opaque_tid(); const int wv = (blockIdx.x * 8 + (tid_ >> 6)), nwv = gridDim.x * 8, lane = tid_ & 63;
    bf16_t* hp = p.h_();
    for (int r0 = wv * 4; r0 < TS; r0 += nwv * 4) { f32x4 v[4][4];
#pragma unroll
        for (int q = 0; q < 4; ++q)
#pragma unroll
            for (int i = 0; i < 4; ++i) v[q][i] = *(const f32x4*)(xs + (size_t)(r0 + q) * DM + i * 256 + lane * 4);
#pragma unroll
        for (int q = 0; q < 4; ++q) { float ss = 0.f;
#pragma unroll
            for (int i = 0; i < 4; ++i) ss += v[q][i][0] * v[q][i][0] + v[q][i][1] * v[q][i][1] + v[q][i][2] * v[q][i][2] + v[q][i][3] * v[q][i][3];
            ss = wave_sum(ss); const float rs = rsqrtf(ss * (1.0f / DM) + EPSN);
#pragma unroll
            for (int i = 0; i < 4; ++i) { u32x2 w; w.x = pk2(v[q][i][0] * rs, v[q][i][1] * rs); w.y = pk2(v[q][i][2] * rs, v[q][i][3] * rs); *(u32x2*)(hp + (size_t)(r0 + q) * DM + i * 256 + lane * 4) = w; } }
    }
}
DI void phase_mknorm(const Params& p) {
    const long gtid = (long)blockIdx.x * 512 + opaque_tid(), gn = (long)gridDim.x * 512;
    for (long i = gtid; i < (long)DEPTH * 2048 * 4 * 16; i += gn) { const int sub = (int)(i & 15); const long rh = i >> 4; const int hd = (int)(rh & 3); const long row = rh >> 2; const int l = (int)(row / 2048);
        bf16_t* ptr = p.mk_() + (size_t)row * 512 + hd * 128 + sub * 8; float f[8]; unpack8(*(const u32x4*)ptr, f); float ss = 0.f;
#pragma unroll
        for (int j = 0; j < 8; ++j) ss += f[j] * f[j];
        ss += shx(ss, 1); ss += shx(ss, 2); ss += shx(ss, 4); ss += shx(ss, 8);
        const float rs = rsqrtf(ss * (1.0f / 128.0f) + EPSN); const float* g = p.mk_g + l * 128 + sub * 8; f32x4 o0, o1;
#pragma unroll
        for (int j = 0; j < 4; ++j) { o0[j] = f[j] * rs * g[j]; o1[j] = f[4 + j] * rs * g[4 + j]; }
        *(u32x4*)ptr = pack8(o0, o1); }
}
DI void phase_rope(const Params& p, int layer) {
    const long gtid = (long)blockIdx.x * 512 + opaque_tid(), gn = (long)gridDim.x * 512;
    for (long i = gtid; i < (long)TS * 32; i += gn) { const int dg = (int)(i & 7), hd = (int)((i >> 3) & 3); const long t = i >> 5; const int pos = (int)(t & (SEQ - 1));
        const f32x4 c0 = *(const f32x4*)(p.rcos_() + (size_t)pos * 64 + dg * 8), c1 = *(const f32x4*)(p.rcos_() + (size_t)pos * 64 + dg * 8 + 4);
        const f32x4 s0 = *(const f32x4*)(p.rsin_() + (size_t)pos * 64 + dg * 8), s1 = *(const f32x4*)(p.rsin_() + (size_t)pos * 64 + dg * 8 + 4);
#pragma unroll
        for (int which = 0; which < 2; ++which) { bf16_t* base = p.pc(2 + which) + (size_t)t * 512 + hd * 128 + dg * 8; const float sc = which ? 0.08838834764831845f : 1.0f;
            float a[8], b[8]; unpack8(*(const u32x4*)base, a); unpack8(*(const u32x4*)(base + 64), b); f32x4 o0, o1, q0, q1;
#pragma unroll
            for (int j = 0; j < 4; ++j) { o0[j] = (a[j] * c0[j] - b[j] * s0[j]) * sc; q0[j] = (b[j] * c0[j] + a[j] * s0[j]) * sc; o1[j] = (a[4 + j] * c1[j] - b[4 + j] * s1[j]) * sc; q1[j] = (b[4 + j] * c1[j] + a[4 + j] * s1[j]) * sc; }
            *(u32x4*)base = pack8(o0, o1); *(u32x4*)(base + 64) = pack8(q0, q1); } }
    for (long i = gtid; i < (long)4 * 64 * (TS / 8); i += gn) { const long tg = i % (TS / 8); const int d = (int)((i / (TS / 8)) & 63), hd = (int)(i / ((long)(TS / 8) * 64));
        const long t0 = tg * 8; const int pos0 = (int)(t0 & (SEQ - 1));
        const f32x4 c0 = *(const f32x4*)(p.rcosT_() + (size_t)d * SEQ + pos0), c1 = *(const f32x4*)(p.rcosT_() + (size_t)d * SEQ + pos0 + 4);
        const f32x4 s0 = *(const f32x4*)(p.rsinT_() + (size_t)d * SEQ + pos0), s1 = *(const f32x4*)(p.rsinT_() + (size_t)d * SEQ + pos0 + 4);
        const float lg2 = log2f(1.0f - exp2f(-5.0f - (float)hd)); bf16_t* base = p.pt(0) + (size_t)(hd * 128 + d) * TS + t0;
        float a[8], b[8]; unpack8(*(const u32x4*)base, a); unpack8(*(const u32x4*)(base + (size_t)64 * TS), b); f32x4 o0, o1, q0, q1;
#pragma unroll
        for (int j = 0; j < 4; ++j) { const float k0 = 0.08838834764831845f * exp2f(lg2 * (float)(63 - ((pos0 + j) & 63))), k1 = 0.08838834764831845f * exp2f(lg2 * (float)(63 - ((pos0 + 4 + j) & 63)));
            o0[j] = (a[j] * c0[j] - b[j] * s0[j]) * k0; q0[j] = (b[j] * c0[j] + a[j] * s0[j]) * k0; o1[j] = (a[4 + j] * c1[j] - b[4 + j] * s1[j]) * k1; q1[j] = (b[4 + j] * c1[j] + a[4 + j] * s1[j]) * k1; }
        *(u32x4*)base = pack8(o0, o1); *(u32x4*)(base + (size_t)64 * TS) = pack8(q0, q1); }
    for (long i = gtid; i < (long)TS * 8 * 2 * 4; i += gn) { const int sub = (int)(i & 3); const long r = i >> 2; const int which = (int)(r & 1); const long r2 = r >> 1; const int un = (int)(r2 & 7); const long t = r2 >> 3; const int pos = (int)(t & (SEQ - 1));
        bf16_t* base = p.pc(6 + which) + (size_t)t * 512 + un * 64 + sub * 8; const float* g = (which ? p.dk_g : p.dq_g) + layer * 64 + sub * 8;
        float a[8], b[8]; unpack8(*(const u32x4*)base, a); unpack8(*(const u32x4*)(base + 32), b); float ss = 0.f;
#pragma unroll
        for (int j = 0; j < 8; ++j) ss += a[j] * a[j] + b[j] * b[j];
        ss += shx(ss, 1); ss += shx(ss, 2); const float rs = rsqrtf(ss * (1.0f / 64.0f) + EPSN) * (which ? 1.0f : 0.125f);
        const f32x4 c0 = *(const f32x4*)(p.dcos_() + (size_t)pos * 32 + sub * 8), c1 = *(const f32x4*)(p.dcos_() + (size_t)pos * 32 + sub * 8 + 4);
        const f32x4 s0 = *(const f32x4*)(p.dsin_() + (size_t)pos * 32 + sub * 8), s1 = *(const f32x4*)(p.dsin_() + (size_t)pos * 32 + sub * 8 + 4);
        f32x4 o0, o1, q0, q1;
#pragma unroll
        for (int j = 0; j < 4; ++j) { const float x0 = a[j] * rs * g[j], y0 = b[j] * rs * g[32 + j], x1 = a[4 + j] * rs * g[4 + j], y1 = b[4 + j] * rs * g[36 + j];
            o0[j] = x0 * c0[j] - y0 * s0[j]; q0[j] = y0 * c0[j] + x0 * s0[j]; o1[j] = x1 * c1[j] - y1 * s1[j]; q1[j] = y1 * c1[j] + x1 * s1[j]; }
        *(u32x4*)base = pack8(o0, o1); *(u32x4*)(base + 32) = pack8(q0, q1); }
}
#define MFMA32(a, b, c) __builtin_amdgcn_mfma_f32_32x32x16_bf16((a), (b), (c), 0, 0, 0)
#define MFMA16(a, b, c) __builtin_amdgcn_mfma_f32_16x16x32_bf16((a), (b), (c), 0, 0, 0)
DI int pi32(int r) { return (r & ~12) | ((r & 4) << 1) | ((r & 8) >> 1); }
DI int crow(int reg, int h) { return (reg & 3) + 8 * (reg >> 2) + 4 * h; }
DI bf16x8 pack_regs(const f32x16& x, int s) { u32x4 w; w.x = pk2(x[8 * s], x[8 * s + 1]); w.y = pk2(x[8 * s + 2], x[8 * s + 3]); w.z = pk2(x[8 * s + 4], x[8 * s + 5]); w.w = pk2(x[8 * s + 6], x[8 * s + 7]); return __builtin_bit_cast(bf16x8, w); }
DI void glds16(const void* g, LAS unsigned char* l) { __builtin_amdgcn_global_load_lds((const unsigned*)g, (LAS unsigned*)l, 16, 0, 0); }

template <int NMAP>
DI void attn_item(LAS unsigned char* lds, const bf16_t* Qr, const float* qg, const bf16_t* Kg, int ldk, const bf16_t* Vtg, int ldv,
                  int ntiles, int wnt_base, float nshift, const bf16_t* gate, bf16_t* outp, const float* hn_g, float lam, float oscale) {
    constexpr int DHM = 128 / NMAP, NKS = DHM / 16;
    const int tid = opaque_tid(), w = __builtin_amdgcn_readfirstlane(tid >> 6), lane = tid & 63, r = lane & 31, h = lane >> 5;
    const int wnt = wnt_base + (NMAP == 2 ? (w >> 1) : 0);
    bf16x8 qf[NMAP][NKS];
    { const bf16_t* qrow = Qr + (size_t)(32 * w + r) * 512;
#pragma unroll
      for (int m = 0; m < NMAP; ++m)
#pragma unroll
          for (int ks = 0; ks < NKS; ++ks) qf[m][ks] = *(const bf16x8*)(qrow + m * DHM + 16 * ks + 8 * h);
      if (NMAP == 1) { float ss = 0.f;
#pragma unroll
          for (int ks = 0; ks < NKS; ++ks) { float f[8]; unpack8(__builtin_bit_cast(u32x4, qf[0][ks]), f);
#pragma unroll
              for (int j = 0; j < 8; ++j) ss += f[j] * f[j]; }
          ss += shx(ss, 32); const float rs = rsqrtf(ss * (1.0f / 128.0f) + EPSN) * 0.08838834764831845f;
#pragma unroll
          for (int ks = 0; ks < NKS; ++ks) { float f[8]; unpack8(__builtin_bit_cast(u32x4, qf[0][ks]), f); const float* g = qg + 16 * ks + 8 * h; f32x4 a, b;
#pragma unroll
              for (int j = 0; j < 4; ++j) { a[j] = f[j] * rs * g[j]; b[j] = f[4 + j] * rs * g[4 + j]; }
              qf[0][ks] = __builtin_bit_cast(bf16x8, pack8(a, b)); } } }
    LAS unsigned char* q1l = lds + 65536 + w * 4096 + lane * 16;
    if (NMAP == 2) {
#pragma unroll
        for (int ks = 0; ks < NKS; ++ks) *(LAS bf16x8*)(q1l + ks * 1024) = qf[NMAP - 1][ks];
    }
    f32x16 o[NMAP][4]; float l[NMAP];
#pragma unroll
    for (int m = 0; m < NMAP; ++m) { l[m] = 0.f;
#pragma unroll
        for (int d = 0; d < 4; ++d)
#pragma unroll
            for (int i = 0; i < 16; ++i) o[m][d][i] = 0.f; }
    unsigned ksrc[2], vsrc[2];
#pragma unroll
    for (int i = 0; i < 2; ++i) { const int slot = 2 * w + i; const int kr = 4 * slot + (lane >> 4), kc = (lane & 15) ^ (kr & 15); ksrc[i] = (unsigned)(kr * ldk * 2 + kc * 16);
        const int vr = 8 * slot + (lane >> 3), vc = (lane & 7) ^ ((vr >> 1) & 7); vsrc[i] = (unsigned)(vr * ldv * 2 + vc * 16); }
    const char* kgb = (const char*)Kg; const char* vgb = (const char*)Vtg;
#define ATT_STAGE(kt, buf) do { const char* kp_ = kgb + (size_t)(kt) * 64 * ldk * 2; const char* vp_ = vgb + (size_t)(kt) * 128; \
        _Pragma("unroll") for (int i_ = 0; i_ < 2; ++i_) { glds16(kp_ + ksrc[i_], lds + (buf) * 16384 + (2 * w + i_) * 1024); glds16(vp_ + vsrc[i_], lds + 32768 + (buf) * 16384 + (2 * w + i_) * 1024); } } while (0)
    const int pr = pi32(r); const unsigned kbase = (unsigned)pr * 256u, kx = (unsigned)((pr & 15) ^ h) << 4;
    const unsigned vbase = (unsigned)r * 128u, vx = (unsigned)(((r >> 1) & 7) ^ h) << 4;
    ATT_STAGE(0, 0);
    for (int kt = 0; kt < ntiles; ++kt) {
        asm volatile("s_waitcnt vmcnt(0)" ::: "memory"); __builtin_amdgcn_s_barrier(); asm volatile("" ::: "memory");
        if (kt + 1 < ntiles) ATT_STAGE(kt + 1, (kt + 1) & 1);
        if (kt < wnt) {
            LAS unsigned char* kb = lds + (kt & 1) * 16384; LAS unsigned char* vb = lds + 32768 + (kt & 1) * 16384;
#pragma unroll 1
            for (int kb2 = 0; kb2 < 2; ++kb2) {
                bf16x8 pf[NMAP][2];
#pragma unroll
                for (int m = 0; m < NMAP; ++m) {
                    f32x16 s;
#pragma unroll
                    for (int i = 0; i < 16; ++i) s[i] = 0.f;
#pragma unroll
                    for (int ks = 0; ks < NKS; ++ks) { const unsigned c = (unsigned)(m * (DHM / 8) + 2 * ks) << 4;
                        const bf16x8 a = *(const LAS bf16x8*)(kb + kb2 * 8192 + kbase + (kx ^ c)); const bf16x8 qb_ = (NMAP == 2 && m == 1) ? *(const LAS bf16x8*)(q1l + ks * 1024) : qf[0][ks]; s = MFMA32(a, qb_, s); }
#pragma unroll
                    for (int i = 0; i < 16; ++i) { const float pv = __builtin_amdgcn_exp2f(fmaf(s[i], 1.4426950408889634f, nshift)); s[i] = pv; l[m] += pv; }
                    pf[m][0] = pack_regs(s, 0); pf[m][1] = pack_regs(s, 1);
                }
#pragma unroll
                for (int s2 = 0; s2 < 2; ++s2) { const unsigned c = (unsigned)(4 * kb2 + 2 * s2) << 4;
#pragma unroll
                    for (int d = 0; d < 4; ++d) { const bf16x8 a = *(const LAS bf16x8*)(vb + d * 4096 + vbase + (vx ^ c));
#pragma unroll
                        for (int m = 0; m < NMAP; ++m) o[m][d] = MFMA32(a, pf[m][s2], o[m][d]); } }
            }
        }
    }
#undef ATT_STAGE
    float inv[NMAP];
#pragma unroll
    for (int m = 0; m < NMAP; ++m) { l[m] += shx(l[m], 32); inv[m] = 1.0f / l[m]; }
    float rs; { int ob = __float_as_int(oscale); asm volatile("" : "+s"(ob)); rs = __int_as_float(ob); }
    if (NMAP == 2) { float ss = 0.f;
#pragma unroll
        for (int d = 0; d < 4; ++d)
#pragma unroll
            for (int i = 0; i < 16; ++i) { const float v = o[0][d][i] * inv[0] - lam * o[NMAP - 1][d][i] * inv[NMAP - 1]; o[0][d][i] = v; ss += v * v; }
        ss += shx(ss, 32); rs *= rsqrtf(ss * (1.0f / 128.0f) + EPSN);
    } else {
#pragma unroll
        for (int d = 0; d < 4; ++d)
#pragma unroll
            for (int i = 0; i < 16; ++i) o[0][d][i] *= inv[0];
    }
    const int tid2 = opaque_tid(); const size_t rowo = (size_t)(32 * (tid2 >> 6) + (tid2 & 31)) * 512; const bf16_t* grow = gate + rowo; bf16_t* orow = outp + rowo;
    u32x2 gwv[4][4]; f32x4 hgv[4][4];
#pragma unroll
    for (int d = 0; d < 4; ++d)
#pragma unroll
        for (int gq = 0; gq < 4; ++gq) { const int dv = 32 * d + 8 * gq + 4 * h; gwv[d][gq] = *(const u32x2*)(grow + dv); if (NMAP == 2) hgv[d][gq] = *(const f32x4*)(hn_g + dv); }
#pragma unroll
    for (int d = 0; d < 4; ++d)
#pragma unroll
        for (int gq = 0; gq < 4; ++gq) { const int dv = 32 * d + 8 * gq + 4 * h; const u32x2 gw = gwv[d][gq];
            const float g0 = lo2f(gw.x), g1 = hi2f(gw.x), g2 = lo2f(gw.y), g3 = hi2f(gw.y); float e0 = rs, e1 = rs, e2 = rs, e3 = rs;
            if (NMAP == 2) { const f32x4 hg = hgv[d][gq]; e0 *= hg[0]; e1 *= hg[1]; e2 *= hg[2]; e3 *= hg[3]; }
            u32x2 ow; ow.x = pk2(o[0][d][4 * gq] * e0 * siluf_(g0), o[0][d][4 * gq + 1] * e1 * siluf_(g1)); ow.y = pk2(o[0][d][4 * gq + 2] * e2 * siluf_(g2), o[0][d][4 * gq + 3] * e3 * siluf_(g3));
            *(u32x2*)(orow + dv) = ow; }
    __builtin_amdgcn_s_barrier();
}
#ifndef TEST_ZFILL
#define TEST_ZFILL 0
#endif
DI void ret_item(LAS unsigned char* lds, const bf16_t* Qg, const bf16_t* Kg, const bf16_t* Ktg, const bf16_t* Vtg, const bf16_t* gate, bf16_t* outp, int hd) {
    const int tid = opaque_tid(), w = __builtin_amdgcn_readfirstlane(tid >> 6), lane = tid & 63, r = lane & 31, h = lane >> 5;
    const float lg2 = log2f(1.0f - exp2f(-5.0f - (float)hd)); const float cdec = exp2f(64.0f * lg2);
    size_t qsrc[2], tsrc[2];
#pragma unroll
    for (int i = 0; i < 2; ++i) { const int slot = 2 * w + i; const int kr = 4 * slot + (lane >> 4), kc = (lane & 15) ^ (kr & 15); qsrc[i] = (size_t)kr * 1024 + kc * 16;
        const int vr = 8 * slot + (lane >> 3), vc = (lane & 7) ^ ((vr >> 1) & 7); tsrc[i] = (size_t)vr * TS * 2 + vc * 16; }
#define RET_STAGE(c, buf) do { const size_t qo = (size_t)(c) * 64 * 1024, to = (size_t)(c) * 128; LAS unsigned char* bb = lds + (buf) * 65536; \
        _Pragma("unroll") for (int i_ = 0; i_ < 2; ++i_) { const int so = (2 * w + i_) * 1024; glds16((const char*)Qg + qo + qsrc[i_], bb + so); glds16((const char*)Kg + qo + qsrc[i_], bb + 16384 + so); \
            glds16((const char*)Ktg + to + tsrc[i_], bb + 32768 + so); glds16((const char*)Vtg + to + tsrc[i_], bb + 49152 + so); } } while (0)
    LAS unsigned char* pimg = lds + 131072; LAS float* red = (LAS float*)(lds + 131072 + 8192);
    f32x16 S[4];
#pragma unroll
    for (int d = 0; d < 4; ++d)
#pragma unroll
        for (int i = 0; i < 16; ++i) S[d][i] = 0.f;
    const int pr = pi32(r);
    const unsigned x16 = (unsigned)((r & 15) ^ h) << 4, x16p = (unsigned)((pr & 15) ^ h) << 4, x8 = (unsigned)(((r >> 1) & 7) ^ h) << 4;
    RET_STAGE(0, 0);
    for (int c = 0; c < SEQ / 64; ++c) {
        if (w < 4 && c > 0) asm volatile("s_waitcnt vmcnt(8)" ::: "memory"); else asm volatile("s_waitcnt vmcnt(0)" ::: "memory");
        __builtin_amdgcn_s_barrier(); asm volatile("" ::: "memory");
        if (c + 1 < SEQ / 64) RET_STAGE(c + 1, (c + 1) & 1);
        LAS unsigned char* qb = lds + (c & 1) * 65536; LAS unsigned char* kb = qb + 16384; LAS unsigned char* ktb = qb + 32768; LAS unsigned char* vtb = qb + 49152;
        if (w < 4) {
            const int jb = w & 1, ib = w >> 1; f32x16 s;
#pragma unroll
            for (int i = 0; i < 16; ++i) s[i] = 0.f;
#pragma unroll
            for (int ks = 0; ks < 8; ++ks) { const unsigned cc = (unsigned)(2 * ks) << 4;
                const bf16x8 a = *(const LAS bf16x8*)(kb + (32 * jb + pr) * 256 + (x16p ^ cc)); const bf16x8 b = *(const LAS bf16x8*)(qb + (32 * ib + r) * 256 + (x16 ^ cc)); s = MFMA32(a, b, s); }
            const int iq = 32 * ib + r;
#pragma unroll
            for (int i = 0; i < 16; ++i) { const int j = 32 * jb + pi32(crow(i, h)); const int dd = iq > j ? iq - j : j - iq; s[i] *= exp2f(lg2 * (float)dd); }
#pragma unroll
            for (int s2 = 0; s2 < 2; ++s2) { const unsigned cc = (unsigned)(4 * jb + 2 * s2) << 4; *(LAS bf16x8*)(pimg + iq * 128 + ((((unsigned)((iq >> 1) & 7) ^ h) << 4) ^ cc)) = pack_regs(s, s2); }
        }
        asm volatile("s_waitcnt lgkmcnt(0)" ::: "memory"); __builtin_amdgcn_s_barrier(); asm volatile("" ::: "memory");
        if (w >= 4) {
#pragma unroll
            for (int i = 0; i < 4; ++i) { const int slot = 4 * (w - 4) + i; const int gr = 4 * slot + (lane >> 4), gc = (lane & 15) ^ (gr & 15);
                glds16((const char*)gate + ((size_t)(c * 64 + gr) * 512) * 2 + gc * 16, kb + slot * 1024); }
        }
        f32x16 o[2];
        if (w < 4) {
            const float qd0 = exp2f(lg2 * (float)(r + 1)), qd1 = exp2f(lg2 * (float)(33 + r));
#pragma unroll
            for (int ib = 0; ib < 2; ++ib)
#pragma unroll
                for (int i = 0; i < 16; ++i) o[ib][i] = 0.f;
#pragma unroll
            for (int d = 0; d < 4; ++d)
#pragma unroll
                for (int s2 = 0; s2 < 2; ++s2) { const bf16x8 a = pack_regs(S[d], s2);
                    const unsigned c0 = (unsigned)(4 * d + 2 * s2), c1 = c0 + 1;
#pragma unroll
                    for (int ib = 0; ib < 2; ++ib) { const int iq = 32 * ib + r; const unsigned sw = (unsigned)(iq & 15);
                        const s16x4 lo = *(const LAS s16x4*)(qb + iq * 256 + ((c0 ^ sw) << 4) + 8 * h); const s16x4 hi = *(const LAS s16x4*)(qb + iq * 256 + ((c1 ^ sw) << 4) + 8 * h);
                        const bf16x8 b = __builtin_shufflevector(lo, hi, 0, 1, 2, 3, 4, 5, 6, 7); o[ib] = MFMA32(a, b, o[ib]); } }
#pragma unroll
            for (int i = 0; i < 16; ++i) { o[0][i] *= qd0; o[1][i] *= qd1; }
            bf16x8 vf[4];
#pragma unroll
            for (int ks = 0; ks < 4; ++ks) vf[ks] = *(const LAS bf16x8*)(vtb + (32 * w + r) * 128 + (x8 ^ ((unsigned)(2 * ks) << 4)));
#pragma unroll
            for (int ib = 0; ib < 2; ++ib) { const int iq = 32 * ib + r;
#pragma unroll
                for (int ks = 0; ks < 4; ++ks) { const bf16x8 b = *(const LAS bf16x8*)(pimg + iq * 128 + (x8 ^ ((unsigned)(2 * ks) << 4))); o[ib] = MFMA32(vf[ks], b, o[ib]); } }
#pragma unroll
            for (int d = 0; d < 4; ++d) {
#pragma unroll
                for (int i = 0; i < 16; ++i) S[d][i] *= cdec;
#pragma unroll
                for (int ks = 0; ks < 4; ++ks) { const bf16x8 a = *(const LAS bf16x8*)(ktb + (32 * d + r) * 128 + (x8 ^ ((unsigned)(2 * ks) << 4))); S[d] = MFMA32(a, vf[ks], S[d]); } }
#pragma unroll
            for (int ib = 0; ib < 2; ++ib) { float ss = 0.f;
#pragma unroll
                for (int i = 0; i < 16; ++i) ss += o[ib][i] * o[ib][i];
                ss += shx(ss, 32); if (h == 0) red[w * 64 + 32 * ib + r] = ss; }
        }
        if (w >= 4) asm volatile("s_waitcnt vmcnt(0)" ::: "memory");
        asm volatile("s_waitcnt lgkmcnt(0)" ::: "memory"); __builtin_amdgcn_s_barrier(); asm volatile("" ::: "memory");
        if (w < 4) {
#pragma unroll
            for (int ib = 0; ib < 2; ++ib) { const int iq = 32 * ib + r; const float tot = red[iq] + red[64 + iq] + red[128 + iq] + red[192 + iq]; const float rs = rsqrtf(tot * (1.0f / 128.0f) + EPSN);
                const bf16_t* grow = gate + (size_t)(c * 64 + iq) * 512 + 32 * w; bf16_t* orow = outp + (size_t)(c * 64 + iq) * 512 + 32 * w;
#pragma unroll
                for (int gq = 0; gq < 4; ++gq) { const int dv = 8 * gq + 4 * h; const u32x2 gw = *(const LAS u32x2*)(kb + iq * 256 + ((((unsigned)(4 * w + gq)) ^ (unsigned)(iq & 15)) << 4) + 8 * h); u32x2 ow;
                    ow.x = pk2(o[ib][4 * gq] * rs * siluf_(lo2f(gw.x)), o[ib][4 * gq + 1] * rs * siluf_(hi2f(gw.x))); ow.y = pk2(o[ib][4 * gq + 2] * rs * siluf_(lo2f(gw.y)), o[ib][4 * gq + 3] * rs * siluf_(hi2f(gw.y)));
                    *(u32x2*)(orow + dv) = ow; } }
        }
    }
#undef RET_STAGE
    __builtin_amdgcn_s_barrier();
}

DI float gelu_tanh(float y) { const float a = 0.7978845608028654f * (y + 0.044715f * y * y * y); const float e = __expf(2.0f * a); return 0.5f * y * (2.0f - 2.0f * __builtin_amdgcn_rcpf(e + 1.0f)); }
DI void s5_item(LAS unsigned char* lds, const Params& p, int layer, int bslab, int g) {
    const int tid_ = opaque_tid(); const int lane = tid_ & 63, w = __builtin_amdgcn_readfirstlane(tid_ >> 6), r = lane & 31, h = lane >> 5, fr = lane & 15, fq = lane >> 4;
    LAS unsigned char* img = lds + w * 8704;
    const int lg = layer * 32 + g;
    bf16x8 bfr[4], cfr[4];
#pragma unroll
    for (int sb = 0; sb < 4; ++sb) bfr[sb] = *(const bf16x8*)(p.bbar_() + ((size_t)lg * 128 + 32 * sb + r) * 16 + 8 * h);
#pragma unroll
    for (int ks = 0; ks < 4; ++ks) cfr[ks] = *(const bf16x8*)(p.cct_() + ((size_t)lg * 16 + fr) * 128 + 32 * ks + 8 * fq);
    const float are = p.abar_()[((size_t)lg * 64 + lane) * 2], aim = p.abar_()[((size_t)lg * 64 + lane) * 2 + 1];
    const f32x4 dsk = *(const f32x4*)(p.ssm_d + layer * 512 + g * 16 + 4 * fq);
    float xr = 0.f, xi = 0.f;
    const bf16_t* ub = p.pc(0) + (size_t)bslab * SEQ * 512 + g * 16; bf16_t* zb = p.zbuf_() + (size_t)bslab * SEQ * 512 + g * 16;
    bf16x8 uf = *(const bf16x8*)(ub + (size_t)r * 512 + 8 * h);
    for (int t0 = 0; t0 < SEQ; t0 += 32) {
        const bf16x8 ucur = uf;
        if (t0 + 32 < SEQ) uf = *(const bf16x8*)(ub + (size_t)(t0 + 32 + r) * 512 + 8 * h);
#pragma unroll
        for (int sb = 0; sb < 4; ++sb) { f32x16 z;
#pragma unroll
            for (int i = 0; i < 16; ++i) z[i] = 0.f;
            z = MFMA32(bfr[sb], ucur, z);
#pragma unroll
            for (int gq = 0; gq < 4; ++gq) { u32x2 wv; wv.x = pk2(z[4 * gq], z[4 * gq + 1]); wv.y = pk2(z[4 * gq + 2], z[4 * gq + 3]); *(LAS u32x2*)(img + r * 272 + (32 * sb + 8 * gq + 4 * h) * 2) = wv; } }
        asm volatile("s_waitcnt lgkmcnt(0)" ::: "memory");
        unsigned short rb[32], ib[32];
#pragma unroll
        for (int t = 0; t < 32; ++t) { LAS bf16_t* row = (LAS bf16_t*)(img + t * 272); rb[t] = row[lane]; ib[t] = row[64 + lane]; }
#pragma unroll
        for (int t = 0; t < 32; ++t) { const float br = bf2f(rb[t]), bi = bf2f(ib[t]);
            const float nr = fmaf(are, xr, fmaf(-aim, xi, br)), ni = fmaf(are, xi, fmaf(aim, xr, bi)); xr = nr; xi = ni; rb[t] = f2bf(xr); ib[t] = f2bf(xi); }
#pragma unroll
        for (int t = 0; t < 32; ++t) { LAS bf16_t* row = (LAS bf16_t*)(img + t * 272); row[lane] = rb[t]; row[64 + lane] = ib[t]; }
        asm volatile("s_waitcnt lgkmcnt(0)" ::: "memory");
#pragma unroll
        for (int tb = 0; tb < 2; ++tb) { f32x4 y = {0.f, 0.f, 0.f, 0.f};
#pragma unroll
            for (int ks = 0; ks < 4; ++ks) { const bf16x8 b = *(const LAS bf16x8*)(img + (16 * tb + fr) * 272 + (32 * ks + 8 * fq) * 2); y = MFMA16(cfr[ks], b, y); }
            const u32x4 uw = __builtin_bit_cast(u32x4, ucur); const int src = 16 * tb + fr + 32 * (fq >> 1);
            const unsigned d0 = shl_u(uw.x, src), d1 = shl_u(uw.y, src), d2 = shl_u(uw.z, src), d3 = shl_u(uw.w, src);
            const unsigned ua = (fq & 1) ? d2 : d0, ubw = (fq & 1) ? d3 : d1;
            const float y0 = y[0] + dsk[0] * lo2f(ua), y1 = y[1] + dsk[1] * hi2f(ua), y2 = y[2] + dsk[2] * lo2f(ubw), y3 = y[3] + dsk[3] * hi2f(ubw);
            u32x2 ow; ow.x = pk2(gelu_tanh(y0), gelu_tanh(y1)); ow.y = pk2(gelu_tanh(y2), gelu_tanh(y3));
            *(u32x2*)(zb + (size_t)(t0 + 16 * tb + fr) * 512 + 4 * fq) = ow; }
    }
}

DI void s5_item_tr(LAS unsigned char* lds, const Params& p, int layer, int bslab, int g, bf16_t* zdst) {
    const int tid_ = opaque_tid(); const int lane = tid_ & 63, w = __builtin_amdgcn_readfirstlane(tid_ >> 6), r = lane & 31, h = lane >> 5, fr = lane & 15, fq = lane >> 4;
    LAS unsigned char* img = lds + w * 10240;
    const int lg = layer * 32 + g;
    bf16x8 bfr[4], cfr[4];
#pragma unroll
    for (int sb = 0; sb < 4; ++sb) bfr[sb] = *(const bf16x8*)(p.bbar_() + ((size_t)lg * 128 + 32 * sb + r) * 16 + 8 * h);
#pragma unroll
    for (int ks = 0; ks < 4; ++ks) cfr[ks] = *(const bf16x8*)(p.cct_() + ((size_t)lg * 16 + fr) * 128 + 32 * ks + 8 * fq);
    const float are = p.abar_()[((size_t)lg * 64 + lane) * 2], aim = p.abar_()[((size_t)lg * 64 + lane) * 2 + 1];
    const f32x4 dsk = *(const f32x4*)(p.ssm_d + layer * 512 + g * 16 + 4 * fq);
    float xr = 0.f, xi = 0.f;
    const bf16_t* ub = p.pc(0) + (size_t)bslab * SEQ * 512 + g * 16; bf16_t* zb = zdst + (size_t)bslab * SEQ * 512 + g * 16;
    bf16x8 uf = *(const bf16x8*)(ub + (size_t)r * 512 + 8 * h);
    typedef __attribute__((address_space(3))) s16x4 lds_s16x4;
    for (int t0 = 0; t0 < SEQ; t0 += 32) {
        const bf16x8 ucur = uf;
        if (t0 + 32 < SEQ) uf = *(const bf16x8*)(ub + (size_t)(t0 + 32 + r) * 512 + 8 * h);
#pragma unroll
        for (int sb = 0; sb < 4; ++sb) { f32x16 z;
#pragma unroll
            for (int i = 0; i < 16; ++i) z[i] = 0.f;
            z = MFMA32(ucur, bfr[sb], z);
#pragma unroll
            for (int gq = 0; gq < 4; ++gq) { u32x2 wv; wv.x = pk2(z[4 * gq], z[4 * gq + 1]); wv.y = pk2(z[4 * gq + 2], z[4 * gq + 3]); *(LAS u32x2*)(img + (32 * sb + r) * 80 + 16 * gq + 8 * h) = wv; } }
        asm volatile("s_waitcnt lgkmcnt(0)" ::: "memory");
        u32x4 rv[4], iv[4];
#pragma unroll
        for (int q = 0; q < 4; ++q) { rv[q] = *(const LAS u32x4*)(img + lane * 80 + 16 * q); iv[q] = *(const LAS u32x4*)(img + (64 + lane) * 80 + 16 * q); }
#pragma unroll
        for (int q = 0; q < 4; ++q)
#pragma unroll
            for (int e = 0; e < 4; ++e) { const unsigned rw = rv[q][e], iw = iv[q][e];
                float nr = fmaf(are, xr, fmaf(-aim, xi, lo2f(rw))), ni = fmaf(are, xi, fmaf(aim, xr, lo2f(iw))); const float r0 = nr, i0 = ni;
                xr = fmaf(are, nr, fmaf(-aim, ni, hi2f(rw))); xi = fmaf(are, ni, fmaf(aim, nr, hi2f(iw)));
                rv[q][e] = pk2(r0, xr); iv[q][e] = pk2(i0, xi); }
#pragma unroll
        for (int q = 0; q < 4; ++q) { *(LAS u32x4*)(img + lane * 80 + 16 * q) = rv[q]; *(LAS u32x4*)(img + (64 + lane) * 80 + 16 * q) = iv[q]; }
        asm volatile("s_waitcnt lgkmcnt(0)" ::: "memory");
#pragma unroll
        for (int tb = 0; tb < 2; ++tb) { f32x4 y = {0.f, 0.f, 0.f, 0.f};
#pragma unroll
            for (int ks = 0; ks < 4; ++ks) { LAS unsigned char* bp = img + (32 * ks + 8 * fq + (fr >> 2)) * 80 + 32 * tb + 8 * (fr & 3);
                const s16x4 lo = __builtin_amdgcn_ds_read_tr16_b64_v4i16((lds_s16x4*)bp), hi = __builtin_amdgcn_ds_read_tr16_b64_v4i16((lds_s16x4*)(bp + 320));
                const bf16x8 b = __builtin_shufflevector(lo, hi, 0, 1, 2, 3, 4, 5, 6, 7); y = MFMA16(cfr[ks], b, y); }
            const u32x4 uw = __builtin_bit_cast(u32x4, ucur); const int src = 16 * tb + fr + 32 * (fq >> 1);
            const unsigned d0 = shl_u(uw.x, src), d1 = shl_u(uw.y, src), d2 = shl_u(uw.z, src), d3 = shl_u(uw.w, src);
            const unsigned ua = (fq & 1) ? d2 : d0, ubw = (fq & 1) ? d3 : d1;
            const float y0 = y[0] + dsk[0] * lo2f(ua), y1 = y[1] + dsk[1] * hi2f(ua), y2 = y[2] + dsk[2] * lo2f(ubw), y3 = y[3] + dsk[3] * hi2f(ubw);
            u32x2 ow; ow.x = pk2(gelu_tanh(y0), gelu_tanh(y1)); ow.y = pk2(gelu_tanh(y2), gelu_tanh(y3));
            *(u32x2*)(zb + (size_t)(t0 + 16 * tb + fr) * 512 + 4 * fq) = ow; }
        asm volatile("s_waitcnt lgkmcnt(0)" ::: "memory");
    }
}
#ifndef TEST_TOL
#define TEST_TOL 0.05f
#endif
#ifndef TEST_MAXBAD
#define TEST_MAXBAD 0u
#endif
#ifndef TEST_TR
#define TEST_TR 2
#endif
#ifndef S5_EXIT
#define S5_EXIT 0
#endif
typedef __attribute__((address_space(4))) const Params CParams;
#if defined(__HIP_DEVICE_COMPILE__)
DI Params load_params() { CParams* kp = (CParams*)__builtin_amdgcn_kernarg_segment_ptr(); asm volatile("" : "+s"(kp)); return *kp; }
#else
DI Params load_params() { return Params{}; }
#endif
DI float rfl(float v) { int i = __builtin_amdgcn_readfirstlane(__float_as_int(v)); asm volatile("" : "+s"(i)); return __int_as_float(i); }
DI void phase_mixers(const Params& p, LAS unsigned char* lds, int layer, int slab, int rep, int mask = 15) {
    const int tid = opaque_tid(), w = __builtin_amdgcn_readfirstlane(tid >> 6);
    const int osb = layer == 0 ? 0x3f4ccccd : 0x3f24fd5c;
    int osb2 = osb; asm volatile("" : "+s"(osb2)); const float oscale_d = __int_as_float(osb2);
    const float* sc = p.scal() + layer * 8; const float lam = rfl(sc[0]), nshift_d = rfl(sc[1]), nshift_m = rfl(sc[2]);
    LAS unsigned* qslot = (LAS unsigned*)(lds + 147440);
    unsigned* ctr = p.ctr_() + (layer * NSLAB + slab) * 256 + rep * 32;
    constexpr int S5W = 4;
    constexpr int N_S5 = SLABB * 32 / S5W, N_RET = SLABB * 4, N_DIFF = SLABB * 4 * 32, N_MEM = SLABB * 4 * 32;
#if STATIC_Q
#define QUEUE_LOOP(CTR, N, ...) for (int item = (int)((blockIdx.x + gridDim.x - (((CTR) - ctr) / 2) % gridDim.x) % gridDim.x); item < (N); item += gridDim.x) { __syncthreads(); __VA_ARGS__ }
#else
#define QUEUE_LOOP(CTR, N, ...) for (;;) { if (tid == 0) *qslot = atomicAdd((CTR), 1u); __syncthreads(); const int item = __builtin_amdgcn_readfirstlane((int)*qslot); __syncthreads(); if (item >= (N)) break; __VA_ARGS__ }
#endif
    bool did_s5 = false;
    if (mask & 1) QUEUE_LOOP(ctr, N_S5, { did_s5 = true;
#if TEST_TR == 1
        if (w < S5W) { const int idx = item * S5W + w; s5_item(lds, p, layer, idx >> 5, idx & 31); } __syncthreads();
        if (w < S5W) { const int idx = item * S5W + w; s5_item_tr(lds, p, layer, idx >> 5, idx & 31, (bf16_t*)(p.wsb + O_END)); } __syncthreads();
#elif TEST_TR == 2
#if TEST_ZFILL
        { const int t2 = opaque_tid(); for (int o = t2 * 16; o < 81920; o += 8192) *(LAS u32x4*)(lds + o) = (u32x4){0u, 0u, 0u, 0u}; __syncthreads(); }
#endif
        if (w < S5W) { const int idx = item * S5W + w; s5_item_tr(lds, p, layer, idx >> 5, idx & 31, p.zbuf_()); } __syncthreads();
#else
        if (w < S5W) { const int idx = item * S5W + w; s5_item(lds, p, layer, idx >> 5, idx & 31); } __syncthreads();
#endif
    })
    if (S5_EXIT && did_s5) return;
    if (mask & 2) QUEUE_LOOP(ctr + 64, N_RET, { const int b = item >> 2, hd = item & 3;
        ret_item(lds, p.pc(2) + (size_t)b * SEQ * 512 + hd * 128, p.pc(3) + (size_t)b * SEQ * 512 + hd * 128, p.pt(0) + (size_t)(hd * 128) * TS + (size_t)b * SEQ,
                 p.pt(1) + (size_t)(hd * 128) * TS + (size_t)b * SEQ, p.pc(5) + (size_t)b * SEQ * 512 + hd * 128, p.pc(13) + (size_t)b * SEQ * 512 + hd * 128, hd); })
    if (mask & 4) QUEUE_LOOP(ctr + 128, N_DIFF, { const int qt = 31 - (item >> 4), b = (item >> 2) & 3, hd = item & 3;
        const size_t qo = ((size_t)b * SEQ + 256 * qt) * 512 + hd * 128;
        attn_item<2>(lds, p.pc(6) + qo, nullptr, p.pc(7) + (size_t)b * SEQ * 512 + hd * 128, 512, p.pt(2) + (size_t)(hd * 128) * TS + (size_t)b * SEQ, TS,
                     4 * qt + 4, 4 * qt + 1, nshift_d, p.pc(9) + qo, p.pc(14) + qo, p.hn_g + layer * 128, lam, oscale_d); })
    if (mask & 8) QUEUE_LOOP(ctr + 192, N_MEM, { const int qt = item >> 4, b = (item >> 2) & 3, hd = item & 3; const int bg = slab * SLABB + b;
        const size_t qo = ((size_t)b * SEQ + 256 * qt) * 512 + hd * 128;
        attn_item<1>(lds, p.pc(10) + qo, p.mq_g + layer * 128, p.mk_() + ((size_t)layer * 2048 + bg * 256) * 512 + hd * 128, 512,
                     p.mvt_() + ((size_t)layer * 512 + hd * 128) * 2048 + bg * 256, 2048, 4, 4, nshift_m, p.pc(11) + qo, p.pc(15) + qo, nullptr, 0.f, 1.0f); })
#undef QUEUE_LOOP
}


#ifndef TIME_REP
#define TIME_REP 0
#endif
#ifndef DBG_MASK
#define DBG_MASK 15
#endif
#ifndef STATIC_Q
#define STATIC_Q 0
#endif
#ifndef DBG_STOP
#define DBG_STOP 0
#endif
DI void dbg_sum(const bf16_t* buf, size_t n, float& acc) {
    const size_t gtid = (size_t)blockIdx.x * 512 + threadIdx.x, gn = (size_t)gridDim.x * 512;
    for (size_t i = gtid; i < n / 4; i += gn) { const u32x2 w = *(const u32x2*)(buf + i * 4); acc += lo2f(w.x) + hi2f(w.x) + lo2f(w.y) + hi2f(w.y); }
}
DI void dbg_finish(const Params& p, float acc) {
    const size_t gtid = (size_t)blockIdx.x * 512 + threadIdx.x, gn = (size_t)gridDim.x * 512;
    for (size_t i = gtid; i < (size_t)NBATCH * SEQ * DM; i += gn) p.out[i] = (i == gtid) ? acc : 0.f;
}
DI void grid_barrier(unsigned* bar, unsigned& gen, unsigned nblk) {
    asm volatile("s_waitcnt vmcnt(0) lgkmcnt(0)" ::: "memory");
    __syncthreads();
    const int t_ = opaque_tid();
    if (__builtin_amdgcn_readfirstlane(t_ >> 6) == 0) {
        __builtin_amdgcn_fence(__ATOMIC_RELEASE, "agent");
        const unsigned target = gen + 1u; unsigned prev = 0u;
        if ((t_ & 63) == 0) prev = __hip_atomic_fetch_add(bar, 1u, __ATOMIC_RELAXED, __HIP_MEMORY_SCOPE_AGENT);
        const unsigned prev_s = (unsigned)__builtin_amdgcn_readfirstlane((int)prev);
        if (prev_s == nblk - 1u) { if ((t_ & 63) == 0) { __hip_atomic_store(bar, 0u, __ATOMIC_RELAXED, __HIP_MEMORY_SCOPE_AGENT); __hip_atomic_store(bar + 64, target, __ATOMIC_RELEASE, __HIP_MEMORY_SCOPE_AGENT); } }
        else if ((t_ & 63) == 0) { while (__hip_atomic_load(bar + 64, __ATOMIC_RELAXED, __HIP_MEMORY_SCOPE_AGENT) < target) __builtin_amdgcn_s_sleep(1); }
        __builtin_amdgcn_fence(__ATOMIC_ACQUIRE, "agent");
    }
    __syncthreads();
    gen += 1u;
}
__global__ void __launch_bounds__(512, 2) fwd_megakernel(Params p_unused) {
    cg::grid_group grid = cg::this_grid();
#define GSYNC() grid_barrier(gbar, gen, (unsigned)G)
    extern __shared__ __attribute__((aligned(16))) unsigned char shm[];
    LAS unsigned char* lds = (LAS unsigned char*)shm;
    const int G = gridDim.x, c = blockIdx.x;
    init_wid_table();
    unsigned gen = 0; unsigned* gbar; { const Params p = load_params(); gbar = (unsigned*)(p.wsb + O_CTR + 6144); }
    { const Params p = load_params(); phase_prep(p, lds); }
    __threadfence(); grid.sync(); __threadfence();
    { const Params p = load_params(); SchedKV S{p, G, c}; EpiKV E{p}; pg8::gemm_phase(lds, 1024, S, E); }
    GSYNC();
#pragma unroll 1
    for (int layer = 0; layer < DEPTH; ++layer)
#pragma unroll 1
        for (int slab = 0; slab < NSLAB; ++slab) {
            { const Params p = load_params(); const float* xin = (layer == 0 ? p.x : p.out) + (size_t)slab * TS * DM; phase_norm(p, xin);
              if (layer == 0 && slab == 0) phase_mknorm(p); }
            GSYNC();
            { const Params p = load_params(); SchedIn S{p, layer, G, c}; EpiIn E{p, layer}; pg8::gemm_phase(lds, 1024, S, E); }
            if (TIME_REP == 1 && layer == 0 && slab == 0) { GSYNC(); const Params p = load_params(); SchedIn S{p, layer, G, c}; EpiIn E{p, layer}; pg8::gemm_phase(lds, 1024, S, E); }
            GSYNC();
            if (DBG_STOP == 1) { const Params p = load_params(); float a_ = 0.f; dbg_sum(p.pcb_(), (size_t)13 * TS * 512, a_); dbg_sum(p.gates_(), (size_t)4 * TS * 1024, a_); dbg_finish(p, a_); return; }
            if (DBG_STOP == 2) { const Params p = load_params(); float a_ = 0.f; dbg_sum(p.pcb_(), (size_t)13 * TS * 512, a_); dbg_finish(p, a_); return; }
            { const Params p = load_params(); phase_mixers(p, lds, layer, slab, 0, DBG_MASK); }
#if TEST_TR == 1
            if (layer == 0 && slab == 0) { GSYNC(); const Params p = load_params(); const bf16_t* za = p.zbuf_(); const bf16_t* zt = (const bf16_t*)(p.wsb + O_END); unsigned bad = 0;
                const size_t gtid = (size_t)blockIdx.x * 512 + opaque_tid(), gn = (size_t)gridDim.x * 512;
                for (size_t i = gtid; i < (size_t)TS * 512; i += gn) { const float a = bf2f(za[i]), b = bf2f(zt[i]); if (!(fabsf(a - b) <= TEST_TOL * (1.0f + fabsf(a)))) ++bad; }
                if (bad) atomicAdd((unsigned*)(p.wsb + O_CTR + 7168), bad); }
#endif
            if (TIME_REP == 2 && layer == 0 && slab == 0) { GSYNC(); const Params p = load_params(); phase_mixers(p, lds, layer, slab, 1); }
            if (TIME_REP >= 4 && TIME_REP <= 7 && layer == 0 && slab == 0) { GSYNC(); const Params p = load_params(); phase_mixers(p, lds, layer, slab, 1, 1 << (TIME_REP - 4)); }
            GSYNC();
            if (DBG_STOP == 3) { const Params p = load_params(); float a_ = 0.f; dbg_sum(p.pcb_(), (size_t)16 * TS * 512, a_); dbg_sum(p.zbuf_(), (size_t)TS * 512, a_); dbg_finish(p, a_); return; }
            { const Params p = load_params(); SchedGlu S{p, layer, G, c}; EpiGlu E{p, layer}; pg8::gemm_phase(lds, 512, S, E); }
            GSYNC();
            if (DBG_STOP == 4) { const Params p = load_params(); float a_ = 0.f; dbg_sum(p.pc(1), (size_t)TS * 512, a_); dbg_finish(p, a_); return; }
            { const Params p = load_params(); SchedMerge S{p, layer, G, c}; EpiMerge E{p.gates_(), p.h_()}; pg8::gemm_phase(lds, 512, S, E); }
            if (TIME_REP == 3 && layer == 0 && slab == 0) { GSYNC(); const Params p = load_params(); SchedMerge S{p, layer, G, c}; EpiMerge E{p.gates_(), p.h_()}; pg8::gemm_phase(lds, 512, S, E); }
            GSYNC();
            if (DBG_STOP == 5) { const Params p = load_params(); float a_ = 0.f; dbg_sum(p.h_(), (size_t)TS * 1024, a_); dbg_finish(p, a_); return; }
            { const Params p = load_params(); const float* xin = (layer == 0 ? p.x : p.out) + (size_t)slab * TS * DM; float* xout = p.out + (size_t)slab * TS * DM; SchedOut S{p, layer, G, c}; EpiOut E{xin, xout}; pg8::gemm_phase(lds, 1024, S, E); }
            GSYNC();
        }
#if TEST_TR == 1
    { const Params p = load_params(); const unsigned bad = *(volatile unsigned*)(p.wsb + O_CTR + 7168); const size_t gtid = (size_t)blockIdx.x * 512 + opaque_tid();
      if (bad > TEST_MAXBAD) p.out[gtid] = 1.0e4f; }
#endif
}

extern "C" void kernel_launch(void* const* d_in, const int* in_sizes, int n_in, void* d_out, int out_size, void* d_ws, size_t ws_size, hipStream_t stream) {
    constexpr size_t kDynLds = 147456;
    static int grid_blocks = 0;
    if (!grid_blocks) {
        int dev = 0, cus = 0, per_cu = 0;
        (void)hipGetDevice(&dev);
        (void)hipDeviceGetAttribute(&cus, hipDeviceAttributeMultiprocessorCount, dev);
        (void)hipFuncSetAttribute((const void*)fwd_megakernel, hipFuncAttributeMaxDynamicSharedMemorySize, (int)kDynLds);
        (void)hipOccupancyMaxActiveBlocksPerMultiprocessor(&per_cu, fwd_megakernel, 512, kDynLds);
        if (per_cu < 1) per_cu = 1;
        grid_blocks = cus * per_cu;
    }
    Params p{};
    const float** f = (const float**)&p;
    for (int i = 0; i < 28; ++i) f[i] = (const float*)d_in[i];
    p.out = (float*)d_out;
    p.wsb = (char*)d_ws; const size_t off = O_END;
    if (off > ws_size) { fprintf(stderr, "workspace too small: need %zu have %zu\n", off, ws_size); return; }
    (void)hipMemsetAsync(p.wsb + O_CTR, 0, 8192, stream);
    void* args[] = {&p};
    hipError_t e = hipLaunchCooperativeKernel((void*)fwd_megakernel, dim3(grid_blocks), dim3(512), args, kDynLds, stream);
    if (e != hipSuccess) fprintf(stderr, "cooperative launch failed: %s (grid %d)\n", hipGetErrorString(e), grid_blocks);
}
```

```cpp
#include <hip/hip_runtime.h>
#include <hip/hip_cooperative_groups.h>
#include <cstdio>
namespace cg = cooperative_groups;
#define LAS __attribute__((address_space(3)))
#define DI __device__ __forceinline__
typedef unsigned short bf16_t;
typedef short bf16x8 __attribute__((ext_vector_type(8)));
typedef short s16x4 __attribute__((ext_vector_type(4)));
typedef float f32x4 __attribute__((ext_vector_type(4)));
typedef float f32x16 __attribute__((ext_vector_type(16)));
typedef unsigned u32x4 __attribute__((ext_vector_type(4)));
typedef unsigned u32x2 __attribute__((ext_vector_type(2)));

constexpr int DM = 1024, NBATCH = 8, SEQ = 8192, DEPTH = 2, BW = 512, INC = 10240, MEML = 256;
constexpr int SLABB = 4, TS = SLABB * SEQ  , NSLAB = NBATCH / SLABB;
constexpr float EPSN = 1e-6f;

DI float bf2f(bf16_t b) { return __uint_as_float(((unsigned)b) << 16); }
DI bf16_t f2bf(float f) { unsigned u = __float_as_uint(f); u += 0x7FFFu + ((u >> 16) & 1u); return (bf16_t)(u >> 16); }
typedef __bf16 bf16n2 __attribute__((ext_vector_type(2)));
typedef float f32x2 __attribute__((ext_vector_type(2)));
DI unsigned pk2(float lo, float hi) { const f32x2 v = {lo, hi}; return __builtin_bit_cast(unsigned, __builtin_convertvector(v, bf16n2)); }
DI float lo2f(unsigned w) { return __uint_as_float(w << 16); }
DI float hi2f(unsigned w) { return __uint_as_float(w & 0xffff0000u); }
DI float sigmoidf_(float v) { return __builtin_amdgcn_rcpf(1.0f + __expf(-v)); }
DI float siluf_(float v) { return v * sigmoidf_(v); }
constexpr int WID_TABLE_OFF = 147456 - 16 - 256;
DI int hw_slot() { unsigned v; asm volatile("s_getreg_b32 %0, hwreg(HW_REG_HW_ID)" : "=s"(v)); return (int)((v & 15u) | (((v >> 4) & 3u) << 4)); }
DI int opaque_tid() { const int slot = hw_slot(); const int wid = __builtin_amdgcn_readfirstlane(*(const LAS int*)(size_t)(WID_TABLE_OFF + slot * 4));
    int lane; asm volatile("v_mbcnt_lo_u32_b32 %0, -1, 0\n\tv_mbcnt_hi_u32_b32 %0, -1, %0" : "=v"(lane)); return (wid << 6) | lane; }
DI void init_wid_table() { const int slot = hw_slot(); if ((threadIdx.x & 63) == 0) *(LAS int*)(size_t)(WID_TABLE_OFF + slot * 4) = (int)(threadIdx.x >> 6); __syncthreads(); }
DI int opaque_lane() { int lane; asm volatile("v_mbcnt_lo_u32_b32 %0, -1, 0\n\tv_mbcnt_hi_u32_b32 %0, -1, %0" : "=v"(lane)); return lane; }
DI float shx(float v, int m) { return __int_as_float(__builtin_amdgcn_ds_bpermute((opaque_lane() ^ m) << 2, __float_as_int(v))); }
DI unsigned shl_u(unsigned v, int src) { return (unsigned)__builtin_amdgcn_ds_bpermute(src << 2, (int)v); }
DI float wave_sum(float v) { for (int o = 32; o > 0; o >>= 1) v += shx(v, o); return v; }
DI float wave_max(float v) { for (int o = 32; o > 0; o >>= 1) v = fmaxf(v, shx(v, o)); return v; }

namespace pg8 {
constexpr int BM = 256, BK = 64, HALF = 128, HTB = HALF * BK * 2, STAGE_BYTES = 8 * HTB, NXCD = 8, WGM = 8;
__host__ __device__ __forceinline__ int lds_byte(int r, int c) { const int st = (r >> 4) * 2 + (c >> 5), rr = r & 15, cc = c & 31, ob = rr * 64 + cc * 2; return st * 1024 + (ob ^ (((ob >> 9) & 1) << 5)); }
__host__ __device__ __forceinline__ void stage_rc(int b, int& R, int& C) { const int st = b / 1024, sb = b % 1024, swz = sb ^ (((sb >> 9) & 1) << 5); R = (st >> 1) * 16 + swz / 64; C = (st & 1) * 32 + (swz % 64) / 2; }
__host__ __device__ __forceinline__ int perm32(int rho) { const int n = rho >> 4, i = rho & 15; return 8 * (i >> 2) + 4 * n + (i & 3); }

struct Unit { const char* A; const char* B; int row0, col0, aux; };

DI void tile_of(int L, int nM, int nN, int& pm, int& pn) {
    const int nwg = nM * nN; int wgid = L; { const int q = nwg / NXCD, r = nwg % NXCD, xcd = wgid % NXCD, off = wgid / NXCD; wgid = (xcd < r ? xcd * (q + 1) : r * (q + 1) + (xcd - r) * q) + off; }
    const int nig = WGM * nN, gid = wgid / nig, fm = gid * WGM, gsz = (nM - fm) < WGM ? (nM - fm) : WGM;
    pm = fm + ((wgid % nig) % gsz); pn = (wgid % nig) / gsz;
}

template <class Epi, class Sched>
DI void gemm_phase(LAS unsigned char* lds, const int K, const Sched& S, const Epi& E) {
    const int tid = opaque_tid(), wid = __builtin_amdgcn_readfirstlane(tid >> 6), lane = tid & 63, wr = wid >> 2, wc = wid & 3, fr = lane & 15, fq = lane >> 4;
    const int nt = K / BK;
    unsigned voffA[2], voffB[2];
#pragma unroll
    for (int i = 0; i < 2; ++i) { int R, C; stage_rc(tid * 16 + i * 8192, R, C); const int Rb = Epi::PERM ? ((R & ~31) + perm32(R & 31)) : R;
        voffA[i] = (unsigned)(R * K + C) * 2u; voffB[i] = (unsigned)(Rb * K + C) * 2u; }
    const size_t kstep = (size_t)(BK * 2);
    const size_t hstep = (size_t)HALF * K * 2;
    const unsigned ldsw = (unsigned)wid * 1024u;
    const int aoff = lds_byte(wr * 64 + fr, fq * 8), boff = lds_byte(wc * 32 + fr, fq * 8);
#define PG8_SA(b, h) (((b) * 2 + (h)) * HTB)
#define PG8_SB(b, h) ((4 + (b) * 2 + (h)) * HTB)
#define PG8_STAGE(bufoff, gbase, voff) do { _Pragma("unroll") for (int _i = 0; _i < 2; ++_i) \
        __builtin_amdgcn_global_load_lds((const unsigned*)((const char*)(gbase) + (voff)[_i]), (LAS unsigned*)(lds + (bufoff) + ldsw + _i * 8192), 16, 0, 0); } while (0)
#define PG8_LDA(dst, b, h) do { _Pragma("unroll") for (int m = 0; m < 4; ++m) _Pragma("unroll") for (int k = 0; k < 2; ++k) dst[m][k] = *(const LAS bf16x8*)(lds + PG8_SA(b, h) + aoff + m * 2048 + k * 1024); } while (0)
#define PG8_LDB(dst, b, h) do { _Pragma("unroll") for (int n = 0; n < 2; ++n) _Pragma("unroll") for (int k = 0; k < 2; ++k) dst[n][k] = *(const LAS bf16x8*)(lds + PG8_SB(b, h) + boff + n * 2048 + k * 1024); } while (0)
#define PG8_MMA(ai, bj, At, Bt) do { __builtin_amdgcn_s_setprio(1); _Pragma("unroll") for (int m = 0; m < 4; ++m) _Pragma("unroll") for (int n = 0; n < 2; ++n) _Pragma("unroll") for (int k = 0; k < 2; ++k) \
        acc[ai][bj][m][n] = __builtin_amdgcn_mfma_f32_16x16x32_bf16(Bt[n][k], At[m][k], acc[ai][bj][m][n], 0, 0, 0); __builtin_amdgcn_s_setprio(0); } while (0)
#define PG8_WAIT_V(n) asm volatile("s_waitcnt vmcnt(" #n ")" ::: "memory")
#define PG8_WAIT_L(n) asm volatile("s_waitcnt lgkmcnt(" #n ")" ::: "memory")
#define PG8_BAR __builtin_amdgcn_s_barrier()
#define PG8_SCHED __builtin_amdgcn_sched_barrier(0)
    Unit cur, nxt; int ui = 0;
    if (!S.next(0, cur)) return;
    f32x4 acc[2][2][4][2];
#pragma unroll
    for (int a = 0; a < 2; ++a)
#pragma unroll
        for (int b = 0; b < 2; ++b)
#pragma unroll
            for (int m = 0; m < 4; ++m)
#pragma unroll
                for (int n = 0; n < 2; ++n) acc[a][b][m][n] = (f32x4){0.f, 0.f, 0.f, 0.f};
    bf16x8 At[4][2], B0[2][2], B1[2][2];
    const char* cA = cur.A; const char* cB = cur.B;
    PG8_STAGE(PG8_SB(0, 0), cB, voffB); PG8_STAGE(PG8_SA(0, 0), cA, voffA); PG8_STAGE(PG8_SB(0, 1), cB + hstep, voffB); PG8_STAGE(PG8_SA(0, 1), cA + hstep, voffA);
    if (wr == 1) PG8_BAR;
    PG8_WAIT_V(4); PG8_BAR;
    PG8_STAGE(PG8_SB(1, 0), cB + kstep, voffB); PG8_STAGE(PG8_SA(1, 0), cA + kstep, voffA); PG8_STAGE(PG8_SB(1, 1), cB + hstep + kstep, voffB);
    PG8_WAIT_V(6); PG8_BAR;
    for (;;) {
        const bool has_next = S.next(ui + 1, nxt);
        const char* nA = has_next ? nxt.A : cA; const char* nB = has_next ? nxt.B : cB;
        for (int t = 0; t < nt; t += 2) {
            const bool last = (t == nt - 2);
            const char* a1 = cA + (size_t)(t + 1) * kstep;
            const char* a2 = last ? nA : cA + (size_t)(t + 2) * kstep; const char* b2 = last ? nB : cB + (size_t)(t + 2) * kstep;
            const char* a3 = a2 + kstep; const char* b3 = b2 + kstep;
            PG8_LDB(B0, 0, 0); PG8_SCHED; PG8_LDA(At, 0, 0); PG8_STAGE(PG8_SA(1, 1), a1 + hstep, voffA);
            PG8_WAIT_L(8); PG8_BAR; PG8_WAIT_L(0); PG8_MMA(0, 0, At, B0); PG8_BAR; PG8_SCHED;
            PG8_LDB(B1, 0, 1); PG8_STAGE(PG8_SB(0, 0), b2, voffB);
            PG8_BAR; PG8_WAIT_L(0); PG8_MMA(0, 1, At, B1); PG8_BAR;
            PG8_LDA(At, 0, 1); PG8_STAGE(PG8_SA(0, 0), a2, voffA);
            PG8_BAR; PG8_WAIT_L(0); PG8_MMA(1, 0, At, B0); PG8_BAR; PG8_SCHED;
            PG8_STAGE(PG8_SB(0, 1), b2 + hstep, voffB);
            PG8_WAIT_V(6); PG8_BAR; PG8_MMA(1, 1, At, B1); PG8_BAR;
            PG8_LDB(B0, 1, 0); PG8_SCHED; PG8_LDA(At, 1, 0); PG8_STAGE(PG8_SA(0, 1), a2 + hstep, voffA);
            PG8_WAIT_L(8); PG8_BAR; PG8_WAIT_L(0); PG8_MMA(0, 0, At, B0); PG8_BAR; PG8_SCHED;
            PG8_LDB(B1, 1, 1); PG8_STAGE(PG8_SB(1, 0), b3, voffB);
            PG8_BAR; PG8_WAIT_L(0); PG8_MMA(0, 1, At, B1); PG8_BAR;
            PG8_LDA(At, 1, 1); PG8_STAGE(PG8_SA(1, 0), a3, voffA);
            PG8_BAR; PG8_WAIT_L(0); PG8_MMA(1, 0, At, B0); PG8_BAR; PG8_SCHED;
            PG8_STAGE(PG8_SB(1, 1), b3 + hstep, voffB);
            PG8_WAIT_V(6); PG8_BAR; PG8_MMA(1, 1, At, B1); PG8_BAR;
        }
        const bool zero = E(acc, cur, wr, wc, fr, fq);
        if (!has_next) break;
        if (zero) {
#pragma unroll
        for (int a = 0; a < 2; ++a)
#pragma unroll
            for (int b = 0; b < 2; ++b)
#pragma unroll
                for (int m = 0; m < 4; ++m)
#pragma unroll
                    for (int n = 0; n < 2; ++n) acc[a][b][m][n] = (f32x4){0.f, 0.f, 0.f, 0.f};
        }
        cur = nxt; cA = nA; cB = nB; ++ui;
    }
    PG8_WAIT_V(0);
    if (wr == 0) PG8_BAR;
    PG8_BAR;
#undef PG8_SA
#undef PG8_SB
#undef PG8_STAGE
#undef PG8_LDA
#undef PG8_LDB
#undef PG8_MMA
#undef PG8_WAIT_V
#undef PG8_WAIT_L
#undef PG8_BAR
#undef PG8_SCHED
}
}
using pg8::Unit;
constexpr size_t al256(size_t v) { return (v + 255) & ~(size_t)255; }
constexpr size_t O_CTR = 0, O_WTIN = 8192, O_WTGLU = O_WTIN + al256((size_t)DEPTH * INC * DM * 2), O_WTBR = O_WTGLU + al256((size_t)DEPTH * 512 * 512 * 2), O_WTOUT = O_WTBR + al256((size_t)DEPTH * 4 * 1024 * 512 * 2),
    O_WTKV = O_WTOUT + al256((size_t)DEPTH * DM * DM * 2), O_MEMH = O_WTKV + al256((size_t)DEPTH * DM * DM * 2), O_MK = O_MEMH + al256((size_t)2048 * DM * 2), O_MVT = O_MK + al256((size_t)DEPTH * 2048 * 512 * 2),
    O_DCOS = O_MVT + al256((size_t)DEPTH * 512 * 2048 * 2), O_DSIN = O_DCOS + al256((size_t)SEQ * 32 * 4), O_RCOS = O_DSIN + al256((size_t)SEQ * 32 * 4), O_RSIN = O_RCOS + al256((size_t)SEQ * 64 * 4),
    O_RCOST = O_RSIN + al256((size_t)SEQ * 64 * 4), O_RSINT = O_RCOST + al256((size_t)SEQ * 64 * 4), O_ABAR = O_RSINT + al256((size_t)SEQ * 64 * 4), O_BBAR = O_ABAR + al256((size_t)DEPTH * 32 * 64 * 2 * 4),
    O_CCT = O_BBAR + al256((size_t)DEPTH * 32 * 128 * 16 * 2), O_H = O_CCT + al256((size_t)DEPTH * 32 * 16 * 128 * 2), O_ZBUF = O_H + al256((size_t)TS * DM * 2), O_GATES = O_ZBUF + al256((size_t)TS * 512 * 2),
    O_PCB = O_GATES + al256((size_t)4 * TS * 1024 * 2), O_END = O_PCB + al256((size_t)16 * TS * 512 * 2);
struct WsView {
    char* b;
    DI unsigned* ctr() const { return (unsigned*)(b + O_CTR); }
    DI bf16_t* at(size_t o) const { return (bf16_t*)(b + o); }
    DI float* fat(size_t o) const { return (float*)(b + o); }
};
struct Params {
    const float *x, *mem, *norm_g, *w_in, *lam_re, *lam_im, *log_dt, *b_re, *b_im, *c_re, *c_im, *ssm_d, *w_glu, *b_glu;
    const float *dq_g, *dk_g, *lq1, *lk1, *lq2, *lk2, *hn_g, *mem_norm_g, *w_mem_kv, *mq_g, *mk_g, *w_branch, *b_merge, *w_out;
    float* out;
    char* wsb;
    DI const float* scal() const { char* b_ = wsb; asm volatile("" : "+s"(b_)); return (const float*)(__attribute__((address_space(1))) char*)(b_ + O_CTR + 4096); }
#define WSF(name, T, OFF) DI T* name##_() const { char* b_ = wsb; asm volatile("" : "+s"(b_)); return (T*)(__attribute__((address_space(1))) char*)(b_ + (OFF)); }
    WSF(ctr, unsigned, O_CTR) WSF(wt_in, bf16_t, O_WTIN) WSF(wt_glu, bf16_t, O_WTGLU) WSF(wt_br, bf16_t, O_WTBR) WSF(wt_out, bf16_t, O_WTOUT) WSF(wt_kv, bf16_t, O_WTKV) WSF(memh, bf16_t, O_MEMH)
    WSF(mk, bf16_t, O_MK) WSF(mvt, bf16_t, O_MVT) WSF(dcos, float, O_DCOS) WSF(dsin, float, O_DSIN) WSF(rcos, float, O_RCOS) WSF(rsin, float, O_RSIN) WSF(rcosT, float, O_RCOST) WSF(rsinT, float, O_RSINT)
    WSF(abar, float, O_ABAR) WSF(bbar, bf16_t, O_BBAR) WSF(cct, bf16_t, O_CCT) WSF(h, bf16_t, O_H) WSF(zbuf, bf16_t, O_ZBUF) WSF(gates, bf16_t, O_GATES) WSF(pcb, bf16_t, O_PCB)
#undef WSF
    DI bf16_t* pc(int i) const { return pcb_() + (size_t)i * TS * 512; }
    DI bf16_t* pt(int i) const { return pcb_() + (size_t)(i == 0 ? 12 : (i == 1 ? 4 : 8)) * TS * 512; }
};

#define FOR_ACC_PERM(...) \
    _Pragma("unroll") for (int ai = 0; ai < 2; ++ai) _Pragma("unroll") for (int m = 0; m < 4; ++m) { const int row = u.row0 + ai * 128 + wr * 64 + m * 16 + fr; \
    _Pragma("unroll") for (int bj = 0; bj < 2; ++bj) { const int col = u.col0 + bj * 128 + wc * 32 + 8 * fq; f32x4& v0 = acc[ai][bj][m][0]; f32x4& v1 = acc[ai][bj][m][1]; __VA_ARGS__ asm volatile("" ::: "memory"); } }

DI u32x4 pack8(const f32x4& v0, const f32x4& v1) { u32x4 w; w.x = pk2(v0[0], v0[1]); w.y = pk2(v0[2], v0[3]); w.z = pk2(v1[0], v1[1]); w.w = pk2(v1[2], v1[3]); return w; }
DI void unpack8(const u32x4 w, float (&f)[8]) { f[0] = lo2f(w.x); f[1] = hi2f(w.x); f[2] = lo2f(w.y); f[3] = hi2f(w.y); f[4] = lo2f(w.z); f[5] = hi2f(w.z); f[6] = lo2f(w.w); f[7] = hi2f(w.w); }

struct EpiIn {
    static constexpr bool PERM = true;
    Params p; int layer;
    DI bool operator()(f32x4 (&acc)[2][2][4][2], const Unit& u, int wr, int wc, int fr, int fq) const {
        const int v = u.aux;
        if (v >= 36) {
            const int sv = v - 36;
            if (sv < 2) {
                bf16_t* dst = p.pt(0); const int hd = (u.row0 >> 7) + wr; const float lg2 = log2f(1.0f - exp2f(-5.0f - (float)hd));
#pragma unroll
                for (int m = 0; m < 4; ++m) { const int d1 = 16 * m + fr; const float* ct_ = p.rcosT_() + (size_t)d1 * SEQ; const float* st_ = p.rsinT_() + (size_t)d1 * SEQ;
                    const size_t r1 = (size_t)(u.row0 + 128 * wr + d1) * TS;
                    f32x4 tb_[2][4];
#pragma unroll
                    for (int bj = 0; bj < 2; ++bj) { const int pos = (u.col0 + bj * 128 + wc * 32 + 8 * fq) & (SEQ - 1);
                        tb_[bj][0] = *(const f32x4*)(ct_ + pos); tb_[bj][1] = *(const f32x4*)(ct_ + pos + 4); tb_[bj][2] = *(const f32x4*)(st_ + pos); tb_[bj][3] = *(const f32x4*)(st_ + pos + 4); }
#pragma unroll
                    for (int bj = 0; bj < 2; ++bj) { const int col = u.col0 + bj * 128 + wc * 32 + 8 * fq; const int pos = col & (SEQ - 1);
                        const f32x4 c0 = tb_[bj][0], c1 = tb_[bj][1], s0 = tb_[bj][2], s1 = tb_[bj][3];
                        const f32x4 a0 = acc[0][bj][m][0], a1 = acc[0][bj][m][1], b0 = acc[1][bj][m][0], b1 = acc[1][bj][m][1]; f32x4 o0, o1, q0, q1;
#pragma unroll
                        for (int j = 0; j < 4; ++j) { const float k0 = 0.08838834764831845f * exp2f(lg2 * (float)(63 - ((pos + j) & 63))), k1 = 0.08838834764831845f * exp2f(lg2 * (float)(63 - ((pos + 4 + j) & 63)));
                            o0[j] = (a0[j] * c0[j] - b0[j] * s0[j]) * k0; q0[j] = (b0[j] * c0[j] + a0[j] * s0[j]) * k0; o1[j] = (a1[j] * c1[j] - b1[j] * s1[j]) * k1; q1[j] = (b1[j] * c1[j] + a1[j] * s1[j]) * k1; }
                        *(u32x4*)(dst + r1 + col) = pack8(o0, o1); *(u32x4*)(dst + r1 + (size_t)64 * TS + col) = pack8(q0, q1); asm volatile("" ::: "memory"); } }
            } else {
                bf16_t* dst = p.pt(sv >> 1);
                FOR_ACC_PERM({ *(u32x4*)(dst + (size_t)row * TS + col) = pack8(v0, v1); })
            }
        } else {
            const int ct = v < 8 ? v : (v < 14 ? v + 2 : v + 4);
            if (ct >= 4 && ct < 8) {
                bf16_t* dst = p.pc(ct >> 1) + u.col0 + 128 * (wc >> 1) + 32 * (wc & 1) + 8 * fq; const float sc = (ct >= 6) ? 0.08838834764831845f : 1.0f; const int f0 = 32 * (wc & 1) + 8 * fq;
                const float* rc_ = p.rcos_(); const float* rs_ = p.rsin_();
#pragma unroll
                for (int ai = 0; ai < 2; ++ai)
#pragma unroll
                  for (int mh = 0; mh < 2; ++mh) { f32x4 tb_[4][4];
#pragma unroll
                    for (int m = 2 * mh; m < 2 * mh + 2; ++m) { const int pos = (u.row0 + ai * 128 + wr * 64 + m * 16 + fr) & (SEQ - 1); const float* cp = rc_ + (size_t)pos * 64 + f0; const float* sp = rs_ + (size_t)pos * 64 + f0;
                        tb_[m][0] = *(const f32x4*)cp; tb_[m][1] = *(const f32x4*)(cp + 4); tb_[m][2] = *(const f32x4*)sp; tb_[m][3] = *(const f32x4*)(sp + 4); }
#pragma unroll
                    for (int m = 2 * mh; m < 2 * mh + 2; ++m) { const int row = u.row0 + ai * 128 + wr * 64 + m * 16 + fr;
                        const f32x4 c0 = tb_[m][0], c1 = tb_[m][1], s0 = tb_[m][2], s1 = tb_[m][3];
                        const f32x4 a0 = acc[ai][0][m][0], a1 = acc[ai][0][m][1], b0 = acc[ai][1][m][0], b1 = acc[ai][1][m][1]; f32x4 o0, o1, q0, q1;
#pragma unroll
                        for (int j = 0; j < 4; ++j) { o0[j] = (a0[j] * c0[j] - b0[j] * s0[j]) * sc; q0[j] = (b0[j] * c0[j] + a0[j] * s0[j]) * sc; o1[j] = (a1[j] * c1[j] - b1[j] * s1[j]) * sc; q1[j] = (b1[j] * c1[j] + a1[j] * s1[j]) * sc; }
                        *(u32x4*)(dst + (size_t)row * 512) = pack8(o0, o1); *(u32x4*)(dst + (size_t)row * 512 + 64) = pack8(q0, q1); } }
            } else if (ct >= 12 && ct < 16) {
                const bool isq = ct < 14; bf16_t* dst = p.pc(ct >> 1) + u.col0 + 64 * wc + 8 * fq; const float* gn = (isq ? p.dq_g : p.dk_g) + layer * 64 + 8 * fq;
                const f32x4 g0 = *(const f32x4*)gn, g1 = *(const f32x4*)(gn + 4), h0 = *(const f32x4*)(gn + 32), h1 = *(const f32x4*)(gn + 36);
                const float* dc_ = p.dcos_(); const float* ds_ = p.dsin_();
#pragma unroll
                for (int ai = 0; ai < 2; ++ai)
#pragma unroll
                  for (int mh = 0; mh < 2; ++mh) { f32x4 tb_[4][4];
#pragma unroll
                    for (int m = 2 * mh; m < 2 * mh + 2; ++m) { const int pos = (u.row0 + ai * 128 + wr * 64 + m * 16 + fr) & (SEQ - 1); const float* cp = dc_ + (size_t)pos * 32 + 8 * fq; const float* sp = ds_ + (size_t)pos * 32 + 8 * fq;
                        tb_[m][0] = *(const f32x4*)cp; tb_[m][1] = *(const f32x4*)(cp + 4); tb_[m][2] = *(const f32x4*)sp; tb_[m][3] = *(const f32x4*)(sp + 4); }
#pragma unroll
                    for (int m = 2 * mh; m < 2 * mh + 2; ++m) { const int row = u.row0 + ai * 128 + wr * 64 + m * 16 + fr;
                        const f32x4 a0 = acc[ai][0][m][0], a1 = acc[ai][0][m][1], b0 = acc[ai][1][m][0], b1 = acc[ai][1][m][1];
                        float ss = 0.f;
#pragma unroll
                        for (int j = 0; j < 4; ++j) ss += a0[j] * a0[j] + a1[j] * a1[j] + b0[j] * b0[j] + b1[j] * b1[j];
                        ss += shx(ss, 16); ss += shx(ss, 32); const float rs = rsqrtf(ss * (1.0f / 64.0f) + EPSN) * (isq ? 0.125f : 1.0f);
                        const f32x4 c0 = tb_[m][0], c1 = tb_[m][1], s0 = tb_[m][2], s1 = tb_[m][3]; f32x4 o0, o1, q0, q1;
#pragma unroll
                        for (int j = 0; j < 4; ++j) { const float x0 = a0[j] * rs * g0[j], y0 = b0[j] * rs * h0[j], x1 = a1[j] * rs * g1[j], y1 = b1[j] * rs * h1[j];
                            o0[j] = x0 * c0[j] - y0 * s0[j]; q0[j] = y0 * c0[j] + x0 * s0[j]; o1[j] = x1 * c1[j] - y1 * s1[j]; q1[j] = y1 * c1[j] + x1 * s1[j]; }
                        *(u32x4*)(dst + (size_t)row * 512) = pack8(o0, o1); *(u32x4*)(dst + (size_t)row * 512 + 32) = pack8(q0, q1); } }
            } else if (ct < 24) { bf16_t* dst = p.pc(ct >> 1);
                FOR_ACC_PERM({ *(u32x4*)(dst + (size_t)row * 512 + col) = pack8(v0, v1); })
            } else {
                const int d0 = u.col0 + 16 * wc + 4 * fq; const float* bm = p.b_merge + (size_t)layer * 4096 + d0;
                const f32x4 b0 = *(const f32x4*)(bm), b1 = *(const f32x4*)(bm + 1024), b2 = *(const f32x4*)(bm + 2048), b3 = *(const f32x4*)(bm + 3072);
                bf16_t* gp = p.gates_() + d0;
#pragma unroll
                for (int ai = 0; ai < 2; ++ai)
#pragma unroll
                    for (int m = 0; m < 4; ++m) { const size_t ro = (size_t)(u.row0 + ai * 128 + wr * 64 + m * 16 + fr) * 1024; f32x4 g0, g1, g2, g3;
#pragma unroll
                        for (int j = 0; j < 4; ++j) { g0[j] = sigmoidf_(fminf(fmaxf(acc[ai][0][m][0][j] + b0[j], -30.f), 30.f)); g1[j] = sigmoidf_(fminf(fmaxf(acc[ai][0][m][1][j] + b1[j], -30.f), 30.f));
                            g2[j] = sigmoidf_(fminf(fmaxf(acc[ai][1][m][0][j] + b2[j], -30.f), 30.f)); g3[j] = sigmoidf_(fminf(fmaxf(acc[ai][1][m][1][j] + b3[j], -30.f), 30.f)); }
                        u32x2 w0, w1, w2, w3;
                        f32x4 r1, r2, r3;
#pragma unroll
                        for (int j = 0; j < 4; ++j) { r1[j] = __builtin_amdgcn_rcpf(g1[j]); r2[j] = __builtin_amdgcn_rcpf(g2[j]); r3[j] = __builtin_amdgcn_rcpf(g3[j]); }
                        w0.x = pk2(g0[0] * r1[0], g0[1] * r1[1]); w0.y = pk2(g0[2] * r1[2], g0[3] * r1[3]); w1.x = pk2(g1[0] * r2[0], g1[1] * r2[1]); w1.y = pk2(g1[2] * r2[2], g1[3] * r2[3]);
                        w2.x = pk2(g2[0] * r3[0], g2[1] * r3[1]); w2.y = pk2(g2[2] * r3[2], g2[3] * r3[3]); w3.x = pk2(g3[0], g3[1]); w3.y = pk2(g3[2], g3[3]);
                        *(u32x2*)(gp + ro) = w0; *(u32x2*)(gp + (size_t)TS * 1024 + ro) = w1; *(u32x2*)(gp + (size_t)2 * TS * 1024 + ro) = w2; *(u32x2*)(gp + (size_t)3 * TS * 1024 + ro) = w3; }
            }
        }
        return true;
    }
};
struct SchedIn {
    Params p; int layer, G, c;
    DI bool next(int i, Unit& u) const {
        const int L = i * G + c; if (L >= (TS / 256) * 42) return false;
        int pm, pn; pg8::tile_of(L, TS / 256, 42, pm, pn);
        const char* W = (const char*)(p.wt_in_() + (size_t)layer * INC * DM); const char* H = (const char*)p.h_();
        u.aux = pn;
        if (pn < 36) { const int ct = pn < 8 ? pn : (pn < 14 ? pn + 2 : pn + 4);
            u.A = H + (size_t)pm * 256 * DM * 2; u.B = W + (size_t)ct * 256 * DM * 2; u.row0 = pm * 256; u.col0 = ct < 24 ? (ct & 1) * 256 : (ct - 24) * 64;
        } else { const int sv = pn - 36; const int piece = sv < 2 ? 3 : (sv < 4 ? 4 : 8);
            u.A = W + (size_t)(piece * 512 + (sv & 1) * 256) * DM * 2; u.B = H + (size_t)pm * 256 * DM * 2; u.row0 = (sv & 1) * 256; u.col0 = pm * 256; }
        return true;
    }
};
struct EpiKV {
    static constexpr bool PERM = true;
    Params p;
    DI bool operator()(f32x4 (&acc)[2][2][4][2], const Unit& u, int wr, int wc, int fr, int fq) const {
        const int layer = u.aux >> 1, sw = u.aux & 1;
        if (sw) { bf16_t* dst = p.mvt_() + (size_t)layer * 512 * 2048; FOR_ACC_PERM({ *(u32x4*)(dst + (size_t)row * 2048 + col) = pack8(v0, v1); }) }
        else { bf16_t* dst = p.mk_() + (size_t)layer * 2048 * 512; FOR_ACC_PERM({ *(u32x4*)(dst + (size_t)row * 512 + col) = pack8(v0, v1); }) }
        return true;
    }
};
struct SchedKV {
    Params p; int G, c;
    DI bool next(int i, Unit& u) const {
        const int L = i * G + c; if (L >= 8 * 8) return false;
        const int pm = L & 7, q = L >> 3, layer = q >> 2, t = q & 3;
        const char* W = (const char*)(p.wt_kv_() + (size_t)layer * 1024 * 1024); const char* H = (const char*)p.memh_();
        if (t < 2) { u.A = H + (size_t)pm * 256 * DM * 2; u.B = W + (size_t)t * 256 * DM * 2; u.row0 = pm * 256; u.col0 = t * 256; u.aux = layer * 2; }
        else { u.A = W + (size_t)(512 + (t - 2) * 256) * DM * 2; u.B = H + (size_t)pm * 256 * DM * 2; u.row0 = (t - 2) * 256; u.col0 = pm * 256; u.aux = layer * 2 + 1; }
        return true;
    }
};
struct EpiGlu {
    static constexpr bool PERM = true;
    Params p; int layer;
    DI bool operator()(f32x4 (&acc)[2][2][4][2], const Unit& u, int wr, int wc, int fr, int fq) const {
        const float* bg = p.b_glu + (size_t)layer * 512; const int colb = u.col0 + wc * 32 + 8 * fq;
        f32x4 bb[2][2];
#pragma unroll
        for (int bj = 0; bj < 2; ++bj) { bb[bj][0] = *(const f32x4*)(bg + colb + bj * 128); bb[bj][1] = *(const f32x4*)(bg + colb + bj * 128 + 4); }
        const bf16_t* zp = p.zbuf_(); bf16_t* gp = p.pc(1);
#pragma unroll
        for (int ai = 0; ai < 2; ++ai) {
            u32x4 zv[4][2], gv[4][2];
#pragma unroll
            for (int m = 0; m < 4; ++m)
#pragma unroll
                for (int bj = 0; bj < 2; ++bj) { const size_t o = (size_t)(u.row0 + ai * 128 + wr * 64 + m * 16 + fr) * 512 + colb + bj * 128; zv[m][bj] = *(const u32x4*)(zp + o); gv[m][bj] = *(const u32x4*)(gp + o); }
#pragma unroll
            for (int m = 0; m < 4; ++m)
#pragma unroll
                for (int bj = 0; bj < 2; ++bj) { const size_t o = (size_t)(u.row0 + ai * 128 + wr * 64 + m * 16 + fr) * 512 + colb + bj * 128; float z[8], g[8]; unpack8(zv[m][bj], z); unpack8(gv[m][bj], g);
                    const f32x4& v0 = acc[ai][bj][m][0]; const f32x4& v1 = acc[ai][bj][m][1]; f32x4 o0, o1;
#pragma unroll
                    for (int j = 0; j < 4; ++j) { o0[j] = z[j] * sigmoidf_(v0[j] + bb[bj][0][j]) * siluf_(g[j]); o1[j] = z[4 + j] * sigmoidf_(v1[j] + bb[bj][1][j]) * siluf_(g[4 + j]); }
                    *(u32x4*)(gp + o) = pack8(o0, o1); }
        }
        return true;
    }
};
struct SchedGlu {
    Params p; int layer, G, c;
    DI bool next(int i, Unit& u) const {
        const int L = i * G + c; if (L >= (TS / 256) * 2) return false;
        const int pm = L >> 1, pn = L & 1;
        u.A = (const char*)(p.zbuf_() + (size_t)pm * 256 * 512); u.B = (const char*)(p.wt_glu_() + (size_t)layer * 512 * 512 + (size_t)pn * 256 * 512); u.row0 = pm * 256; u.col0 = pn * 256; u.aux = 0;
        return true;
    }
};
struct EpiMerge {
    static constexpr bool PERM = true;
    const bf16_t* gates; bf16_t* merged;
    DI bool operator()(f32x4 (&acc)[2][2][4][2], const Unit& u, int wr, int wc, int fr, int fq) const {
        const int n = u.aux; const bool lastn = (n == 3); const bf16_t* g0p = gates + (size_t)n * TS * 1024; const int colb = u.col0 + wc * 32 + 8 * fq;
        u32x4 gv[2][4][2];
#pragma unroll
        for (int ai = 0; ai < 2; ++ai)
#pragma unroll
            for (int m = 0; m < 4; ++m)
#pragma unroll
                for (int bj = 0; bj < 2; ++bj) gv[ai][m][bj] = *(const u32x4*)(g0p + (size_t)(u.row0 + ai * 128 + wr * 64 + m * 16 + fr) * 1024 + colb + bj * 128);
#pragma unroll
        for (int ai = 0; ai < 2; ++ai)
#pragma unroll
            for (int m = 0; m < 4; ++m)
#pragma unroll
                for (int bj = 0; bj < 2; ++bj) { float a[8]; unpack8(gv[ai][m][bj], a); f32x4& v0 = acc[ai][bj][m][0]; f32x4& v1 = acc[ai][bj][m][1];
#pragma unroll
                    for (int j = 0; j < 4; ++j) { v0[j] *= a[j]; v1[j] *= a[4 + j]; }
                    if (lastn) { *(u32x4*)(merged + (size_t)(u.row0 + ai * 128 + wr * 64 + m * 16 + fr) * 1024 + colb + bj * 128) = pack8(v0, v1); v0 = (f32x4){0.f, 0.f, 0.f, 0.f}; v1 = (f32x4){0.f, 0.f, 0.f, 0.f}; } }
        return false;
    }
};
struct SchedMerge {
    Params p; int layer, G, c;
    DI bool next(int i, Unit& u) const {
        const int ti = i >> 2, n = i & 3; const int L = ti * G + c; if (L >= (TS / 256) * 4) return false;
        int pm, pn; pg8::tile_of(L, TS / 256, 4, pm, pn);
        const bf16_t* A = n == 0 ? p.pc(1) : p.pc(12 + n);
        u.A = (const char*)(A + (size_t)pm * 256 * 512); u.B = (const char*)(p.wt_br_() + ((size_t)(layer * 4 + n) * 1024 + (size_t)pn * 256) * 512); u.row0 = pm * 256; u.col0 = pn * 256; u.aux = n;
        return true;
    }
};
struct EpiOut {
    static constexpr bool PERM = false;
    const float* xin; float* xout;
    DI bool operator()(f32x4 (&acc)[2][2][4][2], const Unit& u, int wr, int wc, int fr, int fq) const {
#pragma unroll
        for (int ai = 0; ai < 2; ++ai) { f32x4 xv[4][2][2];
#pragma unroll
            for (int m = 0; m < 4; ++m)
#pragma unroll
                for (int bj = 0; bj < 2; ++bj)
#pragma unroll
                    for (int n = 0; n < 2; ++n) xv[m][bj][n] = *(const f32x4*)(xin + (size_t)(u.row0 + ai * 128 + wr * 64 + m * 16 + fr) * 1024 + u.col0 + wc * 32 + 4 * fq + bj * 128 + n * 16);
#pragma unroll
            for (int m = 0; m < 4; ++m)
#pragma unroll
                for (int bj = 0; bj < 2; ++bj)
#pragma unroll
                    for (int n = 0; n < 2; ++n) *(f32x4*)(xout + (size_t)(u.row0 + ai * 128 + wr * 64 + m * 16 + fr) * 1024 + u.col0 + wc * 32 + 4 * fq + bj * 128 + n * 16) = xv[m][bj][n] + acc[ai][bj][m][n];
        }
        return true;
    }
};
struct SchedOut {
    Params p; int layer, G, c;
    DI bool next(int i, Unit& u) const {
        const int L = i * G + c; if (L >= (TS / 256) * 4) return false;
        int pm, pn; pg8::tile_of(L, TS / 256, 4, pm, pn);
        u.A = (const char*)(p.h_() + (size_t)pm * 256 * 1024); u.B = (const char*)(p.wt_out_() + ((size_t)layer * 1024 + (size_t)pn * 256) * 1024); u.row0 = pm * 256; u.col0 = pn * 256; u.aux = 0;
        return true;
    }
};
DI int win_row(int cidx) {
    if (cidx < 6144) { const int piece = cidx >> 9, lc = cidx & 511, tile = lc >> 8, l = lc & 255;
        if (piece == 2 || piece == 3) { const int head = l >> 7, d = l & 127, bj = d >> 6, rem = d & 63; return (cidx & ~255) + 128 * bj + 32 * (2 * head + (rem >> 5)) + (rem & 31); }
        if (piece == 6 || piece == 7) { const int un = l >> 6, d = l & 63; return (cidx & ~255) + 128 * (d >> 5) + 32 * un + (d & 31); }
        (void)tile; return cidx; }
    const int n = (cidx - 6144) >> 10, d = (cidx - 6144) & 1023, tile = d >> 6, dd = d & 63;
    return 6144 + tile * 256 + 128 * (n >> 1) + 32 * (dd >> 4) + 8 * ((dd & 15) >> 2) + 4 * (n & 1) + (dd & 3); }
template <bool WIN>
DI void transpose_job(LAS float* tl, const float* src, bf16_t* dst, int R, int C, const float* scale, int& tctr) {
    const int ntr = R / 64, ntc = C / 64, nt = ntr * ntc, G = (int)gridDim.x; const int tid_ = opaque_tid(); const int tx = tid_ & 63, ty = tid_ >> 6;
    const int first = ((int)blockIdx.x - (tctr % G) + G) % G;
    tctr += nt;
    for (int t0 = first; t0 < nt; t0 += 4 * G) {
        __syncthreads();
#pragma unroll
        for (int k = 0; k < 4; ++k) { const int t = t0 + k * G; if (t < nt) { const int tr = t / ntc, tc = t - tr * ntc; LAS float* tk = tl + k * (64 * 65);
#pragma unroll
            for (int i = 0; i < 8; ++i) { const int r = ty + 8 * i; float v = src[(size_t)(tr * 64 + r) * C + tc * 64 + tx]; if (scale) v *= scale[tr * 64 + r]; tk[r * 65 + tx] = v; } } }
        __syncthreads();
#pragma unroll
        for (int k = 0; k < 4; ++k) { const int t = t0 + k * G; if (t < nt) { const int tr = t / ntc, tc = t - tr * ntc; const LAS float* tk = tl + k * (64 * 65);
#pragma unroll
            for (int i = 0; i < 8; ++i) { const int cc = ty + 8 * i; const int drow = WIN ? win_row(tc * 64 + cc) : tc * 64 + cc; dst[(size_t)drow * R + tr * 64 + tx] = f2bf(tk[tx * 65 + cc]); } } }
    }
}

DI void phase_prep(const Params& p, LAS unsigned char* lds) {
    LAS float* tl = (LAS float*)lds; int tctr = 0;
    for (int l = 0; l < DEPTH; ++l) {
        transpose_job<true>(tl, p.w_in + (size_t)l * DM * INC, p.wt_in_() + (size_t)l * INC * DM, DM, INC, p.norm_g + l * DM, tctr);
        transpose_job<false>(tl, p.w_glu + (size_t)l * 512 * 512, p.wt_glu_() + (size_t)l * 512 * 512, 512, 512, nullptr, tctr);
        for (int n = 0; n < 4; ++n) transpose_job<false>(tl, p.w_branch + (size_t)(l * 4 + n) * 512 * 1024, p.wt_br_() + (size_t)(l * 4 + n) * 1024 * 512, 512, 1024, nullptr, tctr);
        transpose_job<false>(tl, p.w_out + (size_t)l * DM * DM, p.wt_out_() + (size_t)l * DM * DM, DM, DM, nullptr, tctr);
        transpose_job<false>(tl, p.w_mem_kv + (size_t)l * DM * DM, p.wt_kv_() + (size_t)l * DM * DM, DM, DM, p.mem_norm_g + l * DM, tctr);
    }
    const long gtid = (long)blockIdx.x * 512 + opaque_tid(), gn = (long)gridDim.x * 512;
    for (long i = gtid; i < (long)SEQ * 32; i += gn) { const int pos = (int)(i >> 5), d = (int)(i & 31);
        const float inv = (float)exp(-(double)(2 * d) / 64.0 * 9.210340371976184); const float ang = (float)pos * inv; float s, c; sincosf(ang, &s, &c); p.dcos_()[i] = c; p.dsin_()[i] = s; }
    for (long i = gtid; i < (long)SEQ * 64; i += gn) { const int pos = (int)(i >> 6), d = (int)(i & 63);
        const float lin = (float)d / 63.0f; const float inv = 1.0f / (float)exp((double)lin * 9.210340371976184); const float ang = (float)pos * inv; float s, c; sincosf(ang, &s, &c);
        p.rcos_()[i] = c; p.rsin_()[i] = s; p.rcosT_()[(size_t)d * SEQ + pos] = c; p.rsinT_()[(size_t)d * SEQ + pos] = s; }
    for (long i = gtid; i < (long)DEPTH * 32 * 64; i += gn) { const int pp = (int)(i & 63), g = (int)((i >> 6) & 31), l = (int)(i >> 11);
        const float lr = fminf(p.lam_re[i], -1e-4f), li = p.lam_im[i], dt = expf(p.log_dt[l * 32 + g]);
        const float mag = expf(lr * dt); float sn, cs; sincosf(li * dt, &sn, &cs); const float are = mag * cs, aim = mag * sn;
        const float nr = are - 1.0f, ni = aim, den = lr * lr + li * li; const float fre = (nr * lr + ni * li) / den, fim = (ni * lr - nr * li) / den;
        p.abar_()[i * 2] = are; p.abar_()[i * 2 + 1] = aim;
        bf16_t* bb = p.bbar_() + ((size_t)(l * 32 + g) * 128) * 16; const float* br = p.b_re + i * 16; const float* bi = p.b_im + i * 16;
        for (int hch = 0; hch < 16; ++hch) { bb[(size_t)pp * 16 + hch] = f2bf(fre * br[hch] - fim * bi[hch]); bb[(size_t)(64 + pp) * 16 + hch] = f2bf(fre * bi[hch] + fim * br[hch]); }
        bf16_t* cc = p.cct_() + ((size_t)(l * 32 + g) * 16) * 128;
        for (int hch = 0; hch < 16; ++hch) { const size_t ci = ((size_t)(l * 32 + g) * 16 + hch) * 64 + pp; cc[hch * 128 + pp] = f2bf(p.c_re[ci]); cc[hch * 128 + 64 + pp] = f2bf(-p.c_im[ci]); }
    }
    if (blockIdx.x == 0 && threadIdx.x < 64) { const int lane = threadIdx.x; float* sc = (float*)(p.wsb + O_CTR + 4096);
        for (int l = 0; l < DEPTH; ++l) { const float lam_init = l == 0 ? 0.2f : 0.35550906759096926f;
            float s1 = p.lq1[l * 64 + lane] * p.lk1[l * 64 + lane], s2 = p.lq2[l * 64 + lane] * p.lk2[l * 64 + lane]; s1 = wave_sum(s1); s2 = wave_sum(s2);
            const float mdq = wave_max(fabsf(p.dq_g[l * 64 + lane])), mdk = wave_max(fabsf(p.dk_g[l * 64 + lane]));
            const float mmq = wave_max(fmaxf(fabsf(p.mq_g[l * 128 + lane]), fabsf(p.mq_g[l * 128 + 64 + lane]))), mmk = wave_max(fmaxf(fabsf(p.mk_g[l * 128 + lane]), fabsf(p.mk_g[l * 128 + 64 + lane])));
            if (lane == 0) { sc[l * 8] = expf(s1) - expf(s2) + lam_init; sc[l * 8 + 1] = -8.0f * mdq * mdk * 1.4426950408889634f; sc[l * 8 + 2] = -11.313708498984761f * mmq * mmk * 1.4426950408889634f; } } }
    { const int tid_ = opaque_tid(); const int wv = (blockIdx.x * 8 + (tid_ >> 6)), nwv = gridDim.x * 8, lane = tid_ & 63;
      for (int r = wv; r < NBATCH * MEML; r += nwv) { const float* s = p.mem + (size_t)r * DM; f32x4 v[4]; float ss = 0.f;
#pragma unroll
          for (int i = 0; i < 4; ++i) { v[i] = *(const f32x4*)(s + i * 256 + lane * 4); ss += v[i][0] * v[i][0] + v[i][1] * v[i][1] + v[i][2] * v[i][2] + v[i][3] * v[i][3]; }
          ss = wave_sum(ss); const float rs = rsqrtf(ss * (1.0f / DM) + EPSN);
#pragma unroll
          for (int i = 0; i < 4; ++i) { u32x2 w; w.x = pk2(v[i][0] * rs, v[i][1] * rs); w.y = pk2(v[i][2] * rs, v[i][3] * rs); *(u32x2*)(p.memh_() + (size_t)r * DM + i * 256 + lane * 4) = w; } } }
}

DI void phase_norm(const Params& p, const float* xs) {
    const int tid_ = opaque_tid(); const int wv = (blockIdx.x * 8 + (tid_ >> 6)), nwv = gridDim.x * 8, lane = tid_ & 63;
    bf16_t* hp = p.h_();
    for (int r0 = wv * 4; r0 < TS; r0 += nwv * 4) { f32x4 v[4][4];
#pragma unroll
        for (int q = 0; q < 4; ++q)
#pragma unroll
            for (int i = 0; i < 4; ++i) v[q][i] = *(const f32x4*)(xs + (size_t)(r0 + q) * DM + i * 256 + lane * 4);
#pragma unroll
        for (int q = 0; q < 4; ++q) { float ss = 0.f;
#pragma unroll
            for (int i = 0; i < 4; ++i) ss += v[q][i][0] * v[q][i][0] + v[q][i][1] * v[q][i][1] + v[q][i][2] * v[q][i][2] + v[q][i][3] * v[q][i][3];
            ss = wave_sum(ss); const float rs = rsqrtf(ss * (1.0f / DM) + EPSN);
#pragma unroll
            for (int i = 0; i < 4; ++i) { u32x2 w; w.x = pk2(v[q][i][0] * rs, v[q][i][1] * rs); w.y = pk2(v[q][i][2] * rs, v[q][i][3] * rs); *(u32x2*)(hp + (size_t)(r0 + q) * DM + i * 256 + lane * 4) = w; } }
    }
}
DI void phase_mknorm(const Params& p) {
    const long gtid = (long)blockIdx.x * 512 + opaque_tid(), gn = (long)gridDim.x * 512;
    for (long i = gtid; i < (long)DEPTH * 2048 * 4 * 16; i += gn) { const int sub = (int)(i & 15); const long rh = i >> 4; const int hd = (int)(rh & 3); const long row = rh >> 2; const int l = (int)(row / 2048);
        bf16_t* ptr = p.mk_() + (size_t)row * 512 + hd * 128 + sub * 8; float f[8]; unpack8(*(const u32x4*)ptr, f); float ss = 0.f;
#pragma unroll
        for (int j = 0; j < 8; ++j) ss += f[j] * f[j];
        ss += shx(ss, 1); ss += shx(ss, 2); ss += shx(ss, 4); ss += shx(ss, 8);
        const float rs = rsqrtf(ss * (1.0f / 128.0f) + EPSN); const float* g = p.mk_g + l * 128 + sub * 8; f32x4 o0, o1;
#pragma unroll
        for (int j = 0; j < 4; ++j) { o0[j] = f[j] * rs * g[j]; o1[j] = f[4 + j] * rs * g[4 + j]; }
        *(u32x4*)ptr = pack8(o0, o1); }
}
DI void phase_rope(const Params& p, int layer) {
    const long gtid = (long)blockIdx.x * 512 + opaque_tid(), gn = (long)gridDim.x * 512;
    for (long i = gtid; i < (long)TS * 32; i += gn) { const int dg = (int)(i & 7), hd = (int)((i >> 3) & 3); const long t = i >> 5; const int pos = (int)(t & (SEQ - 1));
        const f32x4 c0 = *(const f32x4*)(p.rcos_() + (size_t)pos * 64 + dg * 8), c1 = *(const f32x4*)(p.rcos_() + (size_t)pos * 64 + dg * 8 + 4);
        const f32x4 s0 = *(const f32x4*)(p.rsin_() + (size_t)pos * 64 + dg * 8), s1 = *(const f32x4*)(p.rsin_() + (size_t)pos * 64 + dg * 8 + 4);
#pragma unroll
        for (int which = 0; which < 2; ++which) { bf16_t* base = p.pc(2 + which) + (size_t)t * 512 + hd * 128 + dg * 8; const float sc = which ? 0.08838834764831845f : 1.0f;
            float a[8], b[8]; unpack8(*(const u32x4*)base, a); unpack8(*(const u32x4*)(base + 64), b); f32x4 o0, o1, q0, q1;
#pragma unroll
            for (int j = 0; j < 4; ++j) { o0[j] = (a[j] * c0[j] - b[j] * s0[j]) * sc; q0[j] = (b[j] * c0[j] + a[j] * s0[j]) * sc; o1[j] = (a[4 + j] * c1[j] - b[4 + j] * s1[j]) * sc; q1[j] = (b[4 + j] * c1[j] + a[4 + j] * s1[j]) * sc; }
            *(u32x4*)base = pack8(o0, o1); *(u32x4*)(base + 64) = pack8(q0, q1); } }
    for (long i = gtid; i < (long)4 * 64 * (TS / 8); i += gn) { const long tg = i % (TS / 8); const int d = (int)((i / (TS / 8)) & 63), hd = (int)(i / ((long)(TS / 8) * 64));
        const long t0 = tg * 8; const int pos0 = (int)(t0 & (SEQ - 1));
        const f32x4 c0 = *(const f32x4*)(p.rcosT_() + (size_t)d * SEQ + pos0), c1 = *(const f32x4*)(p.rcosT_() + (size_t)d * SEQ + pos0 + 4);
        const f32x4 s0 = *(const f32x4*)(p.rsinT_() + (size_t)d * SEQ + pos0), s1 = *(const f32x4*)(p.rsinT_() + (size_t)d * SEQ + pos0 + 4);
        const float lg2 = log2f(1.0f - exp2f(-5.0f - (float)hd)); bf16_t* base = p.pt(0) + (size_t)(hd * 128 + d) * TS + t0;
        float a[8], b[8]; unpack8(*(const u32x4*)base, a); unpack8(*(const u32x4*)(base + (size_t)64 * TS), b); f32x4 o0, o1, q0, q1;
#pragma unroll
        for (int j = 0; j < 4; ++j) { const float k0 = 0.08838834764831845f * exp2f(lg2 * (float)(63 - ((pos0 + j) & 63))), k1 = 0.08838834764831845f * exp2f(lg2 * (float)(63 - ((pos0 + 4 + j) & 63)));
            o0[j] = (a[j] * c0[j] - b[j] * s0[j]) * k0; q0[j] = (b[j] * c0[j] + a[j] * s0[j]) * k0; o1[j] = (a[4 + j] * c1[j] - b[4 + j] * s1[j]) * k1; q1[j] = (b[4 + j] * c1[j] + a[4 + j] * s1[j]) * k1; }
        *(u32x4*)base = pack8(o0, o1); *(u32x4*)(base + (size_t)64 * TS) = pack8(q0, q1); }
    for (long i = gtid; i < (long)TS * 8 * 2 * 4; i += gn) { const int sub = (int)(i & 3); const long r = i >> 2; const int which = (int)(r & 1); const long r2 = r >> 1; const int un = (int)(r2 & 7); const long t = r2 >> 3; const int pos = (int)(t & (SEQ - 1));
        bf16_t* base = p.pc(6 + which) + (size_t)t * 512 + un * 64 + sub * 8; const float* g = (which ? p.dk_g : p.dq_g) + layer * 64 + sub * 8;
        float a[8], b[8]; unpack8(*(const u32x4*)base, a); unpack8(*(const u32x4*)(base + 32), b); float ss = 0.f;
#pragma unroll
        for (int j = 0; j < 8; ++j) ss += a[j] * a[j] + b[j] * b[j];
        ss += shx(ss, 1); ss += shx(ss, 2); const float rs = rsqrtf(ss * (1.0f / 64.0f) + EPSN) * (which ? 1.0f : 0.125f);
        const f32x4 c0 = *(const f32x4*)(p.dcos_() + (size_t)pos * 32 + sub * 8), c1 = *(const f32x4*)(p.dcos_() + (size_t)pos * 32 + sub * 8 + 4);
        const f32x4 s0 = *(const f32x4*)(p.dsin_() + (size_t)pos * 32 + sub * 8), s1 = *(const f32x4*)(p.dsin_() + (size_t)pos * 32 + sub * 8 + 4);
        f32x4 o0, o1, q0, q1;
#pragma unroll
        for (int j = 0; j < 4; ++j) { const float x0 = a[j] * rs * g[j], y0 = b[j] * rs * g[32 + j], x1 = a[4 + j] * rs * g[4 + j], y1 = b[4 + j] * rs * g[36 + j];
            o0[j] = x0 * c0[j] - y0 * s0[j]; q0[j] = y0 * c0[j] + x0 * s0[j]; o1[j] = x1 * c1[j] - y1 * s1[j]; q1[j] = y1 * c1[j] + x1 * s1[j]; }
        *(u32x4*)base = pack8(o0, o1); *(u32x4*)(base + 32) = pack8(q0, q1); }
}
#define MFMA32(a, b, c) __builtin_amdgcn_mfma_f32_32x32x16_bf16((a), (b), (c), 0, 0, 0)
#define MFMA16(a, b, c) __builtin_amdgcn_mfma_f32_16x16x32_bf16((a), (b), (c), 0, 0, 0)
DI int pi32(int r) { return (r & ~12) | ((r & 4) << 1) | ((r & 8) >> 1); }
DI int crow(int reg, int h) { return (reg & 3) + 8 * (reg >> 2) + 4 * h; }
DI bf16x8 pack_regs(const f32x16& x, int s) { u32x4 w; w.x = pk2(x[8 * s], x[8 * s + 1]); w.y = pk2(x[8 * s + 2], x[8 * s + 3]); w.z = pk2(x[8 * s + 4], x[8 * s + 5]); w.w = pk2(x[8 * s + 6], x[8 * s + 7]); return __builtin_bit_cast(bf16x8, w); }
DI void glds16(const void* g, LAS unsigned char* l) { __builtin_amdgcn_global_load_lds((const unsigned*)g, (LAS unsigned*)l, 16, 0, 0); }

template <int NMAP>
DI void attn_item(LAS unsigned char* lds, const bf16_t* Qr, const float* qg, const bf16_t* Kg, int ldk, const bf16_t* Vtg, int ldv,
                  int ntiles, int wnt_base, float nshift, const bf16_t* gate, bf16_t* outp, const float* hn_g, float lam, float oscale) {
    constexpr int DHM = 128 / NMAP, NKS = DHM / 16;
    const int tid = opaque_tid(), w = __builtin_amdgcn_readfirstlane(tid >> 6), lane = tid & 63, r = lane & 31, h = lane >> 5;
    const int wnt = wnt_base + (NMAP == 2 ? (w >> 1) : 0);
    bf16x8 qf[NMAP][NKS];
    { const bf16_t* qrow = Qr + (size_t)(32 * w + r) * 512;
#pragma unroll
      for (int m = 0; m < NMAP; ++m)
#pragma unroll
          for (int ks = 0; ks < NKS; ++ks) qf[m][ks] = *(const bf16x8*)(qrow + m * DHM + 16 * ks + 8 * h);
      if (NMAP == 1) { float ss = 0.f;
#pragma unroll
          for (int ks = 0; ks < NKS; ++ks) { float f[8]; unpack8(__builtin_bit_cast(u32x4, qf[0][ks]), f);
#pragma unroll
              for (int j = 0; j < 8; ++j) ss += f[j] * f[j]; }
          ss += shx(ss, 32); const float rs = rsqrtf(ss * (1.0f / 128.0f) + EPSN) * 0.08838834764831845f;
#pragma unroll
          for (int ks = 0; ks < NKS; ++ks) { float f[8]; unpack8(__builtin_bit_cast(u32x4, qf[0][ks]), f); const float* g = qg + 16 * ks + 8 * h; f32x4 a, b;
#pragma unroll
              for (int j = 0; j < 4; ++j) { a[j] = f[j] * rs * g[j]; b[j] = f[4 + j] * rs * g[4 + j]; }
              qf[0][ks] = __builtin_bit_cast(bf16x8, pack8(a, b)); } } }
    LAS unsigned char* q1l = lds + 65536 + w * 4096 + lane * 16;
    if (NMAP == 2) {
#pragma unroll
        for (int ks = 0; ks < NKS; ++ks) *(LAS bf16x8*)(q1l + ks * 1024) = qf[NMAP - 1][ks];
    }
    f32x16 o[NMAP][4]; float l[NMAP];
#pragma unroll
    for (int m = 0; m < NMAP; ++m) { l[m] = 0.f;
#pragma unroll
        for (int d = 0; d < 4; ++d)
#pragma unroll
            for (int i = 0; i < 16; ++i) o[m][d][i] = 0.f; }
    unsigned ksrc[2], vsrc[2];
#pragma unroll
    for (int i = 0; i < 2; ++i) { const int slot = 2 * w + i; const int kr = 4 * slot + (lane >> 4), kc = (lane & 15) ^ (kr & 15); ksrc[i] = (unsigned)(kr * ldk * 2 + kc * 16);
        const int vr = 8 * slot + (lane >> 3), vc = (lane & 7) ^ ((vr >> 1) & 7); vsrc[i] = (unsigned)(vr * ldv * 2 + vc * 16); }
    const char* kgb = (const char*)Kg; const char* vgb = (const char*)Vtg;
#define ATT_STAGE(kt, buf) do { const char* kp_ = kgb + (size_t)(kt) * 64 * ldk * 2; const char* vp_ = vgb + (size_t)(kt) * 128; \
        _Pragma("unroll") for (int i_ = 0; i_ < 2; ++i_) { glds16(kp_ + ksrc[i_], lds + (buf) * 16384 + (2 * w + i_) * 1024); glds16(vp_ + vsrc[i_], lds + 32768 + (buf) * 16384 + (2 * w + i_) * 1024); } } while (0)
    const int pr = pi32(r); const unsigned kbase = (unsigned)pr * 256u, kx = (unsigned)((pr & 15) ^ h) << 4;
    const unsigned vbase = (unsigned)r * 128u, vx = (unsigned)(((r >> 1) & 7) ^ h) << 4;
    ATT_STAGE(0, 0);
    for (int kt = 0; kt < ntiles; ++kt) {
        asm volatile("s_waitcnt vmcnt(0)" ::: "memory"); __builtin_amdgcn_s_barrier(); asm volatile("" ::: "memory");
        if (kt + 1 < ntiles) ATT_STAGE(kt + 1, (kt + 1) & 1);
        if (kt < wnt) {
            LAS unsigned char* kb = lds + (kt & 1) * 16384; LAS unsigned char* vb = lds + 32768 + (kt & 1) * 16384;
#pragma unroll 1
            for (int kb2 = 0; kb2 < 2; ++kb2) {
                bf16x8 pf[NMAP][2];
#pragma unroll
                for (int m = 0; m < NMAP; ++m) {
                    f32x16 s;
#pragma unroll
                    for (int i = 0; i < 16; ++i) s[i] = 0.f;
#pragma unroll
                    for (int ks = 0; ks < NKS; ++ks) { const unsigned c = (unsigned)(m * (DHM / 8) + 2 * ks) << 4;
                        const bf16x8 a = *(const LAS bf16x8*)(kb + kb2 * 8192 + kbase + (kx ^ c)); const bf16x8 qb_ = (NMAP == 2 && m == 1) ? *(const LAS bf16x8*)(q1l + ks * 1024) : qf[0][ks]; s = MFMA32(a, qb_, s); }
#pragma unroll
                    for (int i = 0; i < 16; ++i) { const float pv = __builtin_amdgcn_exp2f(fmaf(s[i], 1.4426950408889634f, nshift)); s[i] = pv; l[m] += pv; }
                    pf[m][0] = pack_regs(s, 0); pf[m][1] = pack_regs(s, 1);
                }
#pragma unroll
                for (int s2 = 0; s2 < 2; ++s2) { const unsigned c = (unsigned)(4 * kb2 + 2 * s2) << 4;
#pragma unroll
                    for (int d = 0; d < 4; ++d) { const bf16x8 a = *(const LAS bf16x8*)(vb + d * 4096 + vbase + (vx ^ c));
#pragma unroll
                        for (int m = 0; m < NMAP; ++m) o[m][d] = MFMA32(a, pf[m][s2], o[m][d]); } }
            }
        }
    }
#undef ATT_STAGE
    float inv[NMAP];
#pragma unroll
    for (int m = 0; m < NMAP; ++m) { l[m] += shx(l[m], 32); inv[m] = 1.0f / l[m]; }
    float rs; { int ob = __float_as_int(oscale); asm volatile("" : "+s"(ob)); rs = __int_as_float(ob); }
    if (NMAP == 2) { float ss = 0.f;
#pragma unroll
        for (int d = 0; d < 4; ++d)
#pragma unroll
            for (int i = 0; i < 16; ++i) { const float v = o[0][d][i] * inv[0] - lam * o[NMAP - 1][d][i] * inv[NMAP - 1]; o[0][d][i] = v; ss += v * v; }
        ss += shx(ss, 32); rs *= rsqrtf(ss * (1.0f / 128.0f) + EPSN);
    } else {
#pragma unroll
        for (int d = 0; d < 4; ++d)
#pragma unroll
            for (int i = 0; i < 16; ++i) o[0][d][i] *= inv[0];
    }
    const int tid2 = opaque_tid(); const size_t rowo = (size_t)(32 * (tid2 >> 6) + (tid2 & 31)) * 512; const bf16_t* grow = gate + rowo; bf16_t* orow = outp + rowo;
    u32x2 gwv[4][4]; f32x4 hgv[4][4];
#pragma unroll
    for (int d = 0; d < 4; ++d)
#pragma unroll
        for (int gq = 0; gq < 4; ++gq) { const int dv = 32 * d + 8 * gq + 4 * h; gwv[d][gq] = *(const u32x2*)(grow + dv); if (NMAP == 2) hgv[d][gq] = *(const f32x4*)(hn_g + dv); }
#pragma unroll
    for (int d = 0; d < 4; ++d)
#pragma unroll
        for (int gq = 0; gq < 4; ++gq) { const int dv = 32 * d + 8 * gq + 4 * h; const u32x2 gw = gwv[d][gq];
            const float g0 = lo2f(gw.x), g1 = hi2f(gw.x), g2 = lo2f(gw.y), g3 = hi2f(gw.y); float e0 = rs, e1 = rs, e2 = rs, e3 = rs;
            if (NMAP == 2) { const f32x4 hg = hgv[d][gq]; e0 *= hg[0]; e1 *= hg[1]; e2 *= hg[2]; e3 *= hg[3]; }
            u32x2 ow; ow.x = pk2(o[0][d][4 * gq] * e0 * siluf_(g0), o[0][d][4 * gq + 1] * e1 * siluf_(g1)); ow.y = pk2(o[0][d][4 * gq + 2] * e2 * siluf_(g2), o[0][d][4 * gq + 3] * e3 * siluf_(g3));
            *(u32x2*)(orow + dv) = ow; }
    __builtin_amdgcn_s_barrier();
}
#ifndef TEST_ZFILL
#define TEST_ZFILL 0
#endif
DI void ret_item(LAS unsigned char* lds, const bf16_t* Qg, const bf16_t* Kg, const bf16_t* Ktg, const bf16_t* Vtg, const bf16_t* gate, bf16_t* outp, int hd, int c0, int c1) {
    const int tid = opaque_tid(), w = __builtin_amdgcn_readfirstlane(tid >> 6), lane = tid & 63, r = lane & 31, h = lane >> 5;
    const float lg2 = log2f(1.0f - exp2f(-5.0f - (float)hd)); const float cdec = exp2f(64.0f * lg2);
    size_t qsrc[2], tsrc[2];
#pragma unroll
    for (int i = 0; i < 2; ++i) { const int slot = 2 * w + i; const int kr = 4 * slot + (lane >> 4), kc = (lane & 15) ^ (kr & 15); qsrc[i] = (size_t)kr * 1024 + kc * 16;
        const int vr = 8 * slot + (lane >> 3), vc = (lane & 7) ^ ((vr >> 1) & 7); tsrc[i] = (size_t)vr * TS * 2 + vc * 16; }
#define RET_STAGE(c, buf) do { const size_t qo = (size_t)(c) * 64 * 1024, to = (size_t)(c) * 128; LAS unsigned char* bb = lds + (buf) * 65536; \
        _Pragma("unroll") for (int i_ = 0; i_ < 2; ++i_) { const int so = (2 * w + i_) * 1024; glds16((const char*)Qg + qo + qsrc[i_], bb + so); glds16((const char*)Kg + qo + qsrc[i_], bb + 16384 + so); \
            glds16((const char*)Ktg + to + tsrc[i_], bb + 32768 + so); glds16((const char*)Vtg + to + tsrc[i_], bb + 49152 + so); } } while (0)
    LAS unsigned char* pimg = lds + 131072; LAS float* red = (LAS float*)(lds + 131072 + 8192);
    f32x16 S[4];
#pragma unroll
    for (int d = 0; d < 4; ++d)
#pragma unroll
        for (int i = 0; i < 16; ++i) S[d][i] = 0.f;
    const int pr = pi32(r);
    const unsigned x16 = (unsigned)((r & 15) ^ h) << 4, x16p = (unsigned)((pr & 15) ^ h) << 4, x8 = (unsigned)(((r >> 1) & 7) ^ h) << 4;
    if (c0 > 0) {
#define RET_PRESTAGE(c, buf) do { const size_t to = (size_t)(c) * 128; LAS unsigned char* bb = lds + (buf) * 65536; \
        _Pragma("unroll") for (int i_ = 0; i_ < 2; ++i_) { const int so = (2 * w + i_) * 1024; glds16((const char*)Ktg + to + tsrc[i_], bb + 32768 + so); glds16((const char*)Vtg + to + tsrc[i_], bb + 49152 + so); } } while (0)
        RET_PRESTAGE(0, 0);
        for (int c = 0; c < c0; ++c) {
            asm volatile("s_waitcnt vmcnt(0)" ::: "memory"); __builtin_amdgcn_s_barrier(); asm volatile("" ::: "memory");
            if (c + 1 < c0) RET_PRESTAGE(c + 1, (c + 1) & 1);
            if (w < 4) { LAS unsigned char* ktb = lds + (c & 1) * 65536 + 32768; LAS unsigned char* vtb = ktb + 16384; bf16x8 vf[4];
#pragma unroll
                for (int ks = 0; ks < 4; ++ks) vf[ks] = *(const LAS bf16x8*)(vtb + (32 * w + r) * 128 + (x8 ^ ((unsigned)(2 * ks) << 4)));
#pragma unroll
                for (int d = 0; d < 4; ++d) {
#pragma unroll
                    for (int i = 0; i < 16; ++i) S[d][i] *= cdec;
#pragma unroll
                    for (int ks = 0; ks < 4; ++ks) { const bf16x8 a = *(const LAS bf16x8*)(ktb + (32 * d + r) * 128 + (x8 ^ ((unsigned)(2 * ks) << 4))); S[d] = MFMA32(a, vf[ks], S[d]); } } }
        }
#undef RET_PRESTAGE
    }
    RET_STAGE(c0, c0 & 1);
    for (int c = c0; c < c1; ++c) {
        asm volatile("s_waitcnt vmcnt(0)" ::: "memory");
        __builtin_amdgcn_s_barrier(); asm volatile("" ::: "memory");
        if (c + 1 < c1) RET_STAGE(c + 1, (c + 1) & 1);
        LAS unsigned char* qb = lds + (c & 1) * 65536; LAS unsigned char* kb = qb + 16384; LAS unsigned char* ktb = qb + 32768; LAS unsigned char* vtb = qb + 49152;
        if (w < 4) {
            const int jb = w & 1, ib = w >> 1; f32x16 s;
#pragma unroll
            for (int i = 0; i < 16; ++i) s[i] = 0.f;
#pragma unroll
            for (int ks = 0; ks < 8; ++ks) { const unsigned cc = (unsigned)(2 * ks) << 4;
                const bf16x8 a = *(const LAS bf16x8*)(kb + (32 * jb + pr) * 256 + (x16p ^ cc)); const bf16x8 b = *(const LAS bf16x8*)(qb + (32 * ib + r) * 256 + (x16 ^ cc)); s = MFMA32(a, b, s); }
            const int iq = 32 * ib + r;
#pragma unroll
            for (int i = 0; i < 16; ++i) { const int j = 32 * jb + pi32(crow(i, h)); const int dd = iq > j ? iq - j : j - iq; s[i] *= exp2f(lg2 * (float)dd); }
#pragma unroll
            for (int s2 = 0; s2 < 2; ++s2) { const unsigned cc = (unsigned)(4 * jb + 2 * s2) << 4; *(LAS bf16x8*)(pimg + iq * 128 + ((((unsigned)((iq >> 1) & 7) ^ h) << 4) ^ cc)) = pack_regs(s, s2); }
        }
        asm volatile("s_waitcnt lgkmcnt(0)" ::: "memory"); __builtin_amdgcn_s_barrier(); asm volatile("" ::: "memory");
        if (w >= 4) {
#pragma unroll
            for (int i = 0; i < 4; ++i) { const int slot = 4 * (w - 4) + i; const int gr = 4 * slot + (lane >> 4), gc = (lane & 15) ^ (gr & 15);
                glds16((const char*)gate + ((size_t)(c * 64 + gr) * 512) * 2 + gc * 16, kb + slot * 1024); }
        }
        f32x16 o[2];
        if (w < 4) {
            const float qd0 = exp2f(lg2 * (float)(r + 1)), qd1 = exp2f(lg2 * (float)(33 + r));
#pragma unroll
            for (int ib = 0; ib < 2; ++ib)
#pragma unroll
                for (int i = 0; i < 16; ++i) o[ib][i] = 0.f;
#pragma unroll
            for (int d = 0; d < 4; ++d)
#pragma unroll
                for (int s2 = 0; s2 < 2; ++s2) { const bf16x8 a = pack_regs(S[d], s2);
                    const unsigned c0 = (unsigned)(4 * d + 2 * s2), c1 = c0 + 1;
#pragma unroll
                    for (int ib = 0; ib < 2; ++ib) { const int iq = 32 * ib + r; const unsigned sw = (unsigned)(iq & 15);
                        const s16x4 lo = *(const LAS s16x4*)(qb + iq * 256 + ((c0 ^ sw) << 4) + 8 * h); const s16x4 hi = *(const LAS s16x4*)(qb + iq * 256 + ((c1 ^ sw) << 4) + 8 * h);
                        const bf16x8 b = __builtin_shufflevector(lo, hi, 0, 1, 2, 3, 4, 5, 6, 7); o[ib] = MFMA32(a, b, o[ib]); } }
#pragma unroll
            for (int i = 0; i < 16; ++i) { o[0][i] *= qd0; o[1][i] *= qd1; }
            bf16x8 vf[4];
#pragma unroll
            for (int ks = 0; ks < 4; ++ks) vf[ks] = *(const LAS bf16x8*)(vtb + (32 * w + r) * 128 + (x8 ^ ((unsigned)(2 * ks) << 4)));
#pragma unroll
            for (int ib = 0; ib < 2; ++ib) { const int iq = 32 * ib + r;
#pragma unroll
                for (int ks = 0; ks < 4; ++ks) { const bf16x8 b = *(const LAS bf16x8*)(pimg + iq * 128 + (x8 ^ ((unsigned)(2 * ks) << 4))); o[ib] = MFMA32(vf[ks], b, o[ib]); } }
#pragma unroll
            for (int d = 0; d < 4; ++d) {
#pragma unroll
                for (int i = 0; i < 16; ++i) S[d][i] *= cdec;
#pragma unroll
                for (int ks = 0; ks < 4; ++ks) { const bf16x8 a = *(const LAS bf16x8*)(ktb + (32 * d + r) * 128 + (x8 ^ ((unsigned)(2 * ks) << 4))); S[d] = MFMA32(a, vf[ks], S[d]); } }
#pragma unroll
            for (int ib = 0; ib < 2; ++ib) { float ss = 0.f;
#pragma unroll
                for (int i = 0; i < 16; ++i) ss += o[ib][i] * o[ib][i];
                ss += shx(ss, 32); if (h == 0) red[w * 64 + 32 * ib + r] = ss; }
        }
        if (w >= 4) asm volatile("s_waitcnt vmcnt(0)" ::: "memory");
        asm volatile("s_waitcnt lgkmcnt(0)" ::: "memory"); __builtin_amdgcn_s_barrier(); asm volatile("" ::: "memory");
        if (w < 4) {
#pragma unroll
            for (int ib = 0; ib < 2; ++ib) { const int iq = 32 * ib + r; const float tot = red[iq] + red[64 + iq] + red[128 + iq] + red[192 + iq]; const float rs = rsqrtf(tot * (1.0f / 128.0f) + EPSN);
                const bf16_t* grow = gate + (size_t)(c * 64 + iq) * 512 + 32 * w; bf16_t* orow = outp + (size_t)(c * 64 + iq) * 512 + 32 * w;
#pragma unroll
                for (int gq = 0; gq < 4; ++gq) { const int dv = 8 * gq + 4 * h; const u32x2 gw = *(const LAS u32x2*)(kb + iq * 256 + ((((unsigned)(4 * w + gq)) ^ (unsigned)(iq & 15)) << 4) + 8 * h); u32x2 ow;
                    ow.x = pk2(o[ib][4 * gq] * rs * siluf_(lo2f(gw.x)), o[ib][4 * gq + 1] * rs * siluf_(hi2f(gw.x))); ow.y = pk2(o[ib][4 * gq + 2] * rs * siluf_(lo2f(gw.y)), o[ib][4 * gq + 3] * rs * siluf_(hi2f(gw.y)));
                    *(u32x2*)(orow + dv) = ow; } }
        }
    }
#undef RET_STAGE
    __builtin_amdgcn_s_barrier();
}

DI float gelu_tanh(float y) { const float a = 0.7978845608028654f * (y + 0.044715f * y * y * y); const float e = __expf(2.0f * a); return 0.5f * y * (2.0f - 2.0f * __builtin_amdgcn_rcpf(e + 1.0f)); }
DI void s5_item(LAS unsigned char* lds, const Params& p, int layer, int bslab, int g) {
    const int tid_ = opaque_tid(); const int lane = tid_ & 63, w = __builtin_amdgcn_readfirstlane(tid_ >> 6), r = lane & 31, h = lane >> 5, fr = lane & 15, fq = lane >> 4;
    LAS unsigned char* img = lds + w * 8704;
    const int lg = layer * 32 + g;
    bf16x8 bfr[4], cfr[4];
#pragma unroll
    for (int sb = 0; sb < 4; ++sb) bfr[sb] = *(const bf16x8*)(p.bbar_() + ((size_t)lg * 128 + 32 * sb + r) * 16 + 8 * h);
#pragma unroll
    for (int ks = 0; ks < 4; ++ks) cfr[ks] = *(const bf16x8*)(p.cct_() + ((size_t)lg * 16 + fr) * 128 + 32 * ks + 8 * fq);
    const float are = p.abar_()[((size_t)lg * 64 + lane) * 2], aim = p.abar_()[((size_t)lg * 64 + lane) * 2 + 1];
    const f32x4 dsk = *(const f32x4*)(p.ssm_d + layer * 512 + g * 16 + 4 * fq);
    float xr = 0.f, xi = 0.f;
    const bf16_t* ub = p.pc(0) + (size_t)bslab * SEQ * 512 + g * 16; bf16_t* zb = p.zbuf_() + (size_t)bslab * SEQ * 512 + g * 16;
    bf16x8 uf = *(const bf16x8*)(ub + (size_t)r * 512 + 8 * h);
    for (int t0 = 0; t0 < SEQ; t0 += 32) {
        const bf16x8 ucur = uf;
        if (t0 + 32 < SEQ) uf = *(const bf16x8*)(ub + (size_t)(t0 + 32 + r) * 512 + 8 * h);
#pragma unroll
        for (int sb = 0; sb < 4; ++sb) { f32x16 z;
#pragma unroll
            for (int i = 0; i < 16; ++i) z[i] = 0.f;
            z = MFMA32(bfr[sb], ucur, z);
#pragma unroll
            for (int gq = 0; gq < 4; ++gq) { u32x2 wv; wv.x = pk2(z[4 * gq], z[4 * gq + 1]); wv.y = pk2(z[4 * gq + 2], z[4 * gq + 3]); *(LAS u32x2*)(img + r * 272 + (32 * sb + 8 * gq + 4 * h) * 2) = wv; } }
        asm volatile("s_waitcnt lgkmcnt(0)" ::: "memory");
        unsigned short rb[32], ib[32];
#pragma unroll
        for (int t = 0; t < 32; ++t) { LAS bf16_t* row = (LAS bf16_t*)(img + t * 272); rb[t] = row[lane]; ib[t] = row[64 + lane]; }
#pragma unroll
        for (int t = 0; t < 32; ++t) { const float br = bf2f(rb[t]), bi = bf2f(ib[t]);
            const float nr = fmaf(are, xr, fmaf(-aim, xi, br)), ni = fmaf(are, xi, fmaf(aim, xr, bi)); xr = nr; xi = ni; rb[t] = f2bf(xr); ib[t] = f2bf(xi); }
#pragma unroll
        for (int t = 0; t < 32; ++t) { LAS bf16_t* row = (LAS bf16_t*)(img + t * 272); row[lane] = rb[t]; row[64 + lane] = ib[t]; }
        asm volatile("s_waitcnt lgkmcnt(0)" ::: "memory");
#pragma unroll
        for (int tb = 0; tb < 2; ++tb) { f32x4 y = {0.f, 0.f, 0.f, 0.f};
#pragma unroll
            for (int ks = 0; ks < 4; ++ks) { const bf16x8 b = *(const LAS bf16x8*)(img + (16 * tb + fr) * 272 + (32 * ks + 8 * fq) * 2); y = MFMA16(cfr[ks], b, y); }
            const u32x4 uw = __builtin_bit_cast(u32x4, ucur); const int src = 16 * tb + fr + 32 * (fq >> 1);
            const unsigned d0 = shl_u(uw.x, src), d1 = shl_u(uw.y, src), d2 = shl_u(uw.z, src), d3 = shl_u(uw.w, src);
            const unsigned ua = (fq & 1) ? d2 : d0, ubw = (fq & 1) ? d3 : d1;
            const float y0 = y[0] + dsk[0] * lo2f(ua), y1 = y[1] + dsk[1] * hi2f(ua), y2 = y[2] + dsk[2] * lo2f(ubw), y3 = y[3] + dsk[3] * hi2f(ubw);
            u32x2 ow; ow.x = pk2(gelu_tanh(y0), gelu_tanh(y1)); ow.y = pk2(gelu_tanh(y2), gelu_tanh(y3));
            *(u32x2*)(zb + (size_t)(t0 + 16 * tb + fr) * 512 + 4 * fq) = ow; }
    }
}

DI void s5_item_tr(LAS unsigned char* lds, const Params& p, int layer, int bslab, int g, bf16_t* zdst) {
    const int tid_ = opaque_tid(); const int lane = tid_ & 63, w = __builtin_amdgcn_readfirstlane(tid_ >> 6), r = lane & 31, h = lane >> 5, fr = lane & 15, fq = lane >> 4;
    LAS unsigned char* img = lds + w * 10240;
    const int lg = layer * 32 + g;
    bf16x8 bfr[4], cfr[4];
#pragma unroll
    for (int sb = 0; sb < 4; ++sb) bfr[sb] = *(const bf16x8*)(p.bbar_() + ((size_t)lg * 128 + 32 * sb + r) * 16 + 8 * h);
#pragma unroll
    for (int ks = 0; ks < 4; ++ks) cfr[ks] = *(const bf16x8*)(p.cct_() + ((size_t)lg * 16 + fr) * 128 + 32 * ks + 8 * fq);
    const float are = p.abar_()[((size_t)lg * 64 + lane) * 2], aim = p.abar_()[((size_t)lg * 64 + lane) * 2 + 1];
    const f32x4 dsk = *(const f32x4*)(p.ssm_d + layer * 512 + g * 16 + 4 * fq);
    float xr = 0.f, xi = 0.f;
    const bf16_t* ub = p.pc(0) + (size_t)bslab * SEQ * 512 + g * 16; bf16_t* zb = zdst + (size_t)bslab * SEQ * 512 + g * 16;
    bf16x8 uf = *(const bf16x8*)(ub + (size_t)r * 512 + 8 * h);
    typedef __attribute__((address_space(3))) s16x4 lds_s16x4;
    for (int t0 = 0; t0 < SEQ; t0 += 32) {
        const bf16x8 ucur = uf;
        if (t0 + 32 < SEQ) uf = *(const bf16x8*)(ub + (size_t)(t0 + 32 + r) * 512 + 8 * h);
#pragma unroll
        for (int sb = 0; sb < 4; ++sb) { f32x16 z;
#pragma unroll
            for (int i = 0; i < 16; ++i) z[i] = 0.f;
            z = MFMA32(ucur, bfr[sb], z);
#pragma unroll
            for (int gq = 0; gq < 4; ++gq) { u32x2 wv; wv.x = pk2(z[4 * gq], z[4 * gq + 1]); wv.y = pk2(z[4 * gq + 2], z[4 * gq + 3]); *(LAS u32x2*)(img + (32 * sb + r) * 80 + 16 * gq + 8 * h) = wv; } }
        asm volatile("s_waitcnt lgkmcnt(0)" ::: "memory");
        u32x4 rv[4], iv[4];
#pragma unroll
        for (int q = 0; q < 4; ++q) { rv[q] = *(const LAS u32x4*)(img + lane * 80 + 16 * q); iv[q] = *(const LAS u32x4*)(img + (64 + lane) * 80 + 16 * q); }
#pragma unroll
        for (int q = 0; q < 4; ++q)
#pragma unroll
            for (int e = 0; e < 4; ++e) { const unsigned rw = rv[q][e], iw = iv[q][e];
                float nr = fmaf(are, xr, fmaf(-aim, xi, lo2f(rw))), ni = fmaf(are, xi, fmaf(aim, xr, lo2f(iw))); const float r0 = nr, i0 = ni;
                xr = fmaf(are, nr, fmaf(-aim, ni, hi2f(rw))); xi = fmaf(are, ni, fmaf(aim, nr, hi2f(iw)));
                rv[q][e] = pk2(r0, xr); iv[q][e] = pk2(i0, xi); }
#pragma unroll
        for (int q = 0; q < 4; ++q) { *(LAS u32x4*)(img + lane * 80 + 16 * q) = rv[q]; *(LAS u32x4*)(img + (64 + lane) * 80 + 16 * q) = iv[q]; }
        asm volatile("s_waitcnt lgkmcnt(0)" ::: "memory");
#pragma unroll
        for (int tb = 0; tb < 2; ++tb) { f32x4 y = {0.f, 0.f, 0.f, 0.f};
#pragma unroll
            for (int ks = 0; ks < 4; ++ks) { LAS unsigned char* bp = img + (32 * ks + 8 * fq + (fr >> 2)) * 80 + 32 * tb + 8 * (fr & 3);
                const s16x4 lo = __builtin_amdgcn_ds_read_tr16_b64_v4i16((lds_s16x4*)bp), hi = __builtin_amdgcn_ds_read_tr16_b64_v4i16((lds_s16x4*)(bp + 320));
                const bf16x8 b = __builtin_shufflevector(lo, hi, 0, 1, 2, 3, 4, 5, 6, 7); y = MFMA16(cfr[ks], b, y); }
            const u32x4 uw = __builtin_bit_cast(u32x4, ucur); const int src = 16 * tb + fr + 32 * (fq >> 1);
            const unsigned d0 = shl_u(uw.x, src), d1 = shl_u(uw.y, src), d2 = shl_u(uw.z, src), d3 = shl_u(uw.w, src);
            const unsigned ua = (fq & 1) ? d2 : d0, ubw = (fq & 1) ? d3 : d1;
            const float y0 = y[0] + dsk[0] * lo2f(ua), y1 = y[1] + dsk[1] * hi2f(ua), y2 = y[2] + dsk[2] * lo2f(ubw), y3 = y[3] + dsk[3] * hi2f(ubw);
            u32x2 ow; ow.x = pk2(gelu_tanh(y0), gelu_tanh(y1)); ow.y = pk2(gelu_tanh(y2), gelu_tanh(y3));
            *(u32x2*)(zb + (size_t)(t0 + 16 * tb + fr) * 512 + 4 * fq) = ow; }
        asm volatile("s_waitcnt lgkmcnt(0)" ::: "memory");
    }
}
#ifndef TEST_TOL
#define TEST_TOL 0.05f
#endif
#ifndef TEST_MAXBAD
#define TEST_MAXBAD 0u
#endif
#ifndef TEST_TR
#define TEST_TR 2
#endif
#ifndef S5_EXIT
#define S5_EXIT 0
#endif
typedef __attribute__((address_space(4))) const Params CParams;
#if defined(__HIP_DEVICE_COMPILE__)
DI Params load_params() { CParams* kp = (CParams*)__builtin_amdgcn_kernarg_segment_ptr(); asm volatile("" : "+s"(kp)); return *kp; }
#else
DI Params load_params() { return Params{}; }
#endif
DI float rfl(float v) { int i = __builtin_amdgcn_readfirstlane(__float_as_int(v)); asm volatile("" : "+s"(i)); return __int_as_float(i); }
DI void phase_mixers(const Params& p, LAS unsigned char* lds, int layer, int slab, int rep, int mask = 15) {
    const int tid = opaque_tid(), w = __builtin_amdgcn_readfirstlane(tid >> 6);
    const int osb = layer == 0 ? 0x3f4ccccd : 0x3f24fd5c;
    int osb2 = osb; asm volatile("" : "+s"(osb2)); const float oscale_d = __int_as_float(osb2);
    const float* sc = p.scal() + layer * 8; const float lam = rfl(sc[0]), nshift_d = rfl(sc[1]), nshift_m = rfl(sc[2]);
    LAS unsigned* qslot = (LAS unsigned*)(lds + 147440);
    unsigned* ctr = p.ctr_() + (layer * NSLAB + slab) * 256 + rep * 32;
    constexpr int S5W = 4;
    constexpr int N_S5 = SLABB * 32 / S5W, N_RET = SLABB * 4 * 2, N_DIFF = SLABB * 4 * 32, N_MEM = SLABB * 4 * 32;
#if STATIC_Q
#define QUEUE_LOOP(CTR, N, ...) for (int item = (int)((blockIdx.x + gridDim.x - (((CTR) - ctr) / 2) % gridDim.x) % gridDim.x); item < (N); item += gridDim.x) { __syncthreads(); __VA_ARGS__ }
#else
#define QUEUE_LOOP(CTR, N, ...) for (;;) { if (tid == 0) *qslot = atomicAdd((CTR), 1u); __syncthreads(); const int item = __builtin_amdgcn_readfirstlane((int)*qslot); __syncthreads(); if (item >= (N)) break; __VA_ARGS__ }
#endif
    bool did_s5 = false;
    if (mask & 1) QUEUE_LOOP(ctr, N_S5, { did_s5 = true;
#if TEST_TR == 1
        if (w < S5W) { const int idx = item * S5W + w; s5_item(lds, p, layer, idx >> 5, idx & 31); } __syncthreads();
        if (w < S5W) { const int idx = item * S5W + w; s5_item_tr(lds, p, layer, idx >> 5, idx & 31, (bf16_t*)(p.wsb + O_END)); } __syncthreads();
#elif TEST_TR == 2
#if TEST_ZFILL
        { const int t2 = opaque_tid(); for (int o = t2 * 16; o < 81920; o += 8192) *(LAS u32x4*)(lds + o) = (u32x4){0u, 0u, 0u, 0u}; __syncthreads(); }
#endif
        if (w < S5W) { const int idx = item * S5W + w; s5_item_tr(lds, p, layer, idx >> 5, idx & 31, p.zbuf_()); } __syncthreads();
#else
        if (w < S5W) { const int idx = item * S5W + w; s5_item(lds, p, layer, idx >> 5, idx & 31); } __syncthreads();
#endif
    })
    if (S5_EXIT && did_s5) return;
    if (mask & 2) QUEUE_LOOP(ctr + 64, N_RET, { const int half = item < SLABB * 4 ? 1 : 0, e_ = item & (SLABB * 4 - 1), b = e_ >> 2, hd = e_ & 3;
        ret_item(lds, p.pc(2) + (size_t)b * SEQ * 512 + hd * 128, p.pc(3) + (size_t)b * SEQ * 512 + hd * 128, p.pt(0) + (size_t)(hd * 128) * TS + (size_t)b * SEQ,
                 p.pt(1) + (size_t)(hd * 128) * TS + (size_t)b * SEQ, p.pc(5) + (size_t)b * SEQ * 512 + hd * 128, p.pc(13) + (size_t)b * SEQ * 512 + hd * 128, hd, half * (SEQ / 128), half * (SEQ / 128) + SEQ / 128); })
    if (mask & 4) QUEUE_LOOP(ctr + 128, N_DIFF, { const int qt = 31 - (item >> 4), b = (item >> 2) & 3, hd = item & 3;
        const size_t qo = ((size_t)b * SEQ + 256 * qt) * 512 + hd * 128;
        attn_item<2>(lds, p.pc(6) + qo, nullptr, p.pc(7) + (size_t)b * SEQ * 512 + hd * 128, 512, p.pt(2) + (size_t)(hd * 128) * TS + (size_t)b * SEQ, TS,
                     4 * qt + 4, 4 * qt + 1, nshift_d, p.pc(9) + qo, p.pc(14) + qo, p.hn_g + layer * 128, lam, oscale_d); })
    if (mask & 8) QUEUE_LOOP(ctr + 192, N_MEM, { const int qt = item >> 4, b = (item >> 2) & 3, hd = item & 3; const int bg = slab * SLABB + b;
        const size_t qo = ((size_t)b * SEQ + 256 * qt) * 512 + hd * 128;
        attn_item<1>(lds, p.pc(10) + qo, p.mq_g + layer * 128, p.mk_() + ((size_t)layer * 2048 + bg * 256) * 512 + hd * 128, 512,
                     p.mvt_() + ((size_t)layer * 512 + hd * 128) * 2048 + bg * 256, 2048, 4, 4, nshift_m, p.pc(11) + qo, p.pc(15) + qo, nullptr, 0.f, 1.0f); })
#undef QUEUE_LOOP
}


#ifndef TIME_REP
#define TIME_REP 0
#endif
#ifndef DBG_MASK
#define DBG_MASK 15
#endif
#ifndef STATIC_Q
#define STATIC_Q 0
#endif
#ifndef DBG_STOP
#define DBG_STOP 0
#endif
DI void dbg_sum(const bf16_t* buf, size_t n, float& acc) {
    const size_t gtid = (size_t)blockIdx.x * 512 + threadIdx.x, gn = (size_t)gridDim.x * 512;
    for (size_t i = gtid; i < n / 4; i += gn) { const u32x2 w = *(const u32x2*)(buf + i * 4); acc += lo2f(w.x) + hi2f(w.x) + lo2f(w.y) + hi2f(w.y); }
}
DI void dbg_finish(const Params& p, float acc) {
    const size_t gtid = (size_t)blockIdx.x * 512 + threadIdx.x, gn = (size_t)gridDim.x * 512;
    for (size_t i = gtid; i < (size_t)NBATCH * SEQ * DM; i += gn) p.out[i] = (i == gtid) ? acc : 0.f;
}
DI void grid_barrier(unsigned* bar, unsigned& gen, unsigned nblk) {
    asm volatile("s_waitcnt vmcnt(0) lgkmcnt(0)" ::: "memory");
    __syncthreads();
    const int t_ = opaque_tid();
    if (__builtin_amdgcn_readfirstlane(t_ >> 6) == 0) {
        __builtin_amdgcn_fence(__ATOMIC_RELEASE, "agent");
        const unsigned target = gen + 1u; unsigned prev = 0u;
        if ((t_ & 63) == 0) prev = __hip_atomic_fetch_add(bar, 1u, __ATOMIC_RELAXED, __HIP_MEMORY_SCOPE_AGENT);
        const unsigned prev_s = (unsigned)__builtin_amdgcn_readfirstlane((int)prev);
        if (prev_s == nblk - 1u) { if ((t_ & 63) == 0) { __hip_atomic_store(bar, 0u, __ATOMIC_RELAXED, __HIP_MEMORY_SCOPE_AGENT); __hip_atomic_store(bar + 64, target, __ATOMIC_RELEASE, __HIP_MEMORY_SCOPE_AGENT); } }
        else if ((t_ & 63) == 0) { while (__hip_atomic_load(bar + 64, __ATOMIC_RELAXED, __HIP_MEMORY_SCOPE_AGENT) < target) __builtin_amdgcn_s_sleep(1); }
        __builtin_amdgcn_fence(__ATOMIC_ACQUIRE, "agent");
    }
    __syncthreads();
    gen += 1u;
}
__global__ void __launch_bounds__(512, 2) fwd_megakernel(Params p_unused) {
    cg::grid_group grid = cg::this_grid();
#define GSYNC() grid_barrier(gbar, gen, (unsigned)G)
    extern __shared__ __attribute__((aligned(16))) unsigned char shm[];
    LAS unsigned char* lds = (LAS unsigned char*)shm;
    const int G = gridDim.x, c = blockIdx.x;
    init_wid_table();
    unsigned gen = 0; unsigned* gbar; { const Params p = load_params(); gbar = (unsigned*)(p.wsb + O_CTR + 6144); }
    { const Params p = load_params(); phase_prep(p, lds); }
    __threadfence(); grid.sync(); __threadfence();
    { const Params p = load_params(); SchedKV S{p, G, c}; EpiKV E{p}; pg8::gemm_phase(lds, 1024, S, E); }
    GSYNC();
#pragma unroll 1
    for (int layer = 0; layer < DEPTH; ++layer)
#pragma unroll 1
        for (int slab = 0; slab < NSLAB; ++slab) {
            { const Params p = load_params(); const float* xin = (layer == 0 ? p.x : p.out) + (size_t)slab * TS * DM; phase_norm(p, xin);
              if (layer == 0 && slab == 0) phase_mknorm(p); }
            GSYNC();
            { const Params p = load_params(); SchedIn S{p, layer, G, c}; EpiIn E{p, layer}; pg8::gemm_phase(lds, 1024, S, E); }
            if (TIME_REP == 1 && layer == 0 && slab == 0) { GSYNC(); const Params p = load_params(); SchedIn S{p, layer, G, c}; EpiIn E{p, layer}; pg8::gemm_phase(lds, 1024, S, E); }
            GSYNC();
            if (DBG_STOP == 1) { const Params p = load_params(); float a_ = 0.f; dbg_sum(p.pcb_(), (size_t)13 * TS * 512, a_); dbg_sum(p.gates_(), (size_t)4 * TS * 1024, a_); dbg_finish(p, a_); return; }
            if (DBG_STOP == 2) { const Params p = load_params(); float a_ = 0.f; dbg_sum(p.pcb_(), (size_t)13 * TS * 512, a_); dbg_finish(p, a_); return; }
            { const Params p = load_params(); phase_mixers(p, lds, layer, slab, 0, DBG_MASK); }
#if TEST_TR == 1
            if (layer == 0 && slab == 0) { GSYNC(); const Params p = load_params(); const bf16_t* za = p.zbuf_(); const bf16_t* zt = (const bf16_t*)(p.wsb + O_END); unsigned bad = 0;
                const size_t gtid = (size_t)blockIdx.x * 512 + opaque_tid(), gn = (size_t)gridDim.x * 512;
                for (size_t i = gtid; i < (size_t)TS * 512; i += gn) { const float a = bf2f(za[i]), b = bf2f(zt[i]); if (!(fabsf(a - b) <= TEST_TOL * (1.0f + fabsf(a)))) ++bad; }
                if (bad) atomicAdd((unsigned*)(p.wsb + O_CTR + 7168), bad); }
#endif
            if (TIME_REP == 2 && layer == 0 && slab == 0) { GSYNC(); const Params p = load_params(); phase_mixers(p, lds, layer, slab, 1); }
            if (TIME_REP >= 4 && TIME_REP <= 7 && layer == 0 && slab == 0) { GSYNC(); const Params p = load_params(); phase_mixers(p, lds, layer, slab, 1, 1 << (TIME_REP - 4)); }
            GSYNC();
            if (DBG_STOP == 3) { const Params p = load_params(); float a_ = 0.f; dbg_sum(p.pcb_(), (size_t)16 * TS * 512, a_); dbg_sum(p.zbuf_(), (size_t)TS * 512, a_); dbg_finish(p, a_); return; }
            { const Params p = load_params(); SchedGlu S{p, layer, G, c}; EpiGlu E{p, layer}; pg8::gemm_phase(lds, 512, S, E); }
            GSYNC();
            if (DBG_STOP == 4) { const Params p = load_params(); float a_ = 0.f; dbg_sum(p.pc(1), (size_t)TS * 512, a_); dbg_finish(p, a_); return; }
            { const Params p = load_params(); SchedMerge S{p, layer, G, c}; EpiMerge E{p.gates_(), p.h_()}; pg8::gemm_phase(lds, 512, S, E); }
            if (TIME_REP == 3 && layer == 0 && slab == 0) { GSYNC(); const Params p = load_params(); SchedMerge S{p, layer, G, c}; EpiMerge E{p.gates_(), p.h_()}; pg8::gemm_phase(lds, 512, S, E); }
            GSYNC();
            if (DBG_STOP == 5) { const Params p = load_params(); float a_ = 0.f; dbg_sum(p.h_(), (size_t)TS * 1024, a_); dbg_finish(p, a_); return; }
            { const Params p = load_params(); const float* xin = (layer == 0 ? p.x : p.out) + (size_t)slab * TS * DM; float* xout = p.out + (size_t)slab * TS * DM; SchedOut S{p, layer, G, c}; EpiOut E{xin, xout}; pg8::gemm_phase(lds, 1024, S, E); }
            GSYNC();
        }
#if TEST_TR == 1
    { const Params p = load_params(); const unsigned bad = *(volatile unsigned*)(p.wsb + O_CTR + 7168); const size_t gtid = (size_t)blockIdx.x * 512 + opaque_tid();
      if (bad > TEST_MAXBAD) p.out[gtid] = 1.0e4f; }
#endif
}

extern "C" void kernel_launch(void* const* d_in, const int* in_sizes, int n_in, void* d_out, int out_size, void* d_ws, size_t ws_size, hipStream_t stream) {
    constexpr size_t kDynLds = 147456;
    static int grid_blocks = 0;
    if (!grid_blocks) {
        int dev = 0, cus = 0, per_cu = 0;
        (void)hipGetDevice(&dev);
        (void)hipDeviceGetAttribute(&cus, hipDeviceAttributeMultiprocessorCount, dev);
        (void)hipFuncSetAttribute((const void*)fwd_megakernel, hipFuncAttributeMaxDynamicSharedMemorySize, (int)kDynLds);
        (void)hipOccupancyMaxActiveBlocksPerMultiprocessor(&per_cu, fwd_megakernel, 512, kDynLds);
        if (per_cu < 1) per_cu = 1;
        grid_blocks = cus * per_cu;
    }
    Params p{};
    const float** f = (const float**)&p;
    for (int i = 0; i < 28; ++i) f[i] = (const float*)d_in[i];
    p.out = (float*)d_out;
    p.wsb = (char*)d_ws; const size_t off = O_END;
    if (off > ws_size) { fprintf(stderr, "workspace too small: need %zu have %zu\n", off, ws_size); return; }
    (void)hipMemsetAsync(p.wsb + O_CTR, 0, 8192, stream);
    void* args[] = {&p};
    hipError_t e = hipLaunchCooperativeKernel((void*)fwd_megakernel, dim3(grid_blocks), dim3(512), args, kDynLds, stream);
    if (e != hipSuccess) fprintf(stderr, "cooperative launch failed: %s (grid %d)\n", hipGetErrorString(e), grid_blocks);
}
```
